# Optimizing an MI355X kernel written in HIP

```python
import math
import jax
import jax.numpy as jnp
from jax import lax
import numpy as np

D_MODEL = 1024
BATCH = 8
SEQ = 4096
DEPTH = 1
DEC_BATCH = 8
DEC_SEQ = 64
PAST_LEN = 4096

CHUNK = 64
Q_BLOCK = 128
MIX_WIDTH = D_MODEL
RET_WIDTH = MIX_WIDTH // 2
DIFF_WIDTH = MIX_WIDTH - RET_WIDTH
RET_HEADS = 4
RET_DK = RET_WIDTH // RET_HEADS
RET_DV = RET_WIDTH // RET_HEADS
DIFF_HEADS = 4
DIFF_DV = DIFF_WIDTH // DIFF_HEADS
DIFF_DK = DIFF_DV // 2
ROT_DIM = DIFF_DK // 4
ROPE_THETA = 500000.0
RET_THETA = 10000.0
D_FF = 2816
EPS = 1e-6
IN_SPLITS = [RET_WIDTH, 2 * RET_WIDTH, 3 * RET_WIDTH, 4 * RET_WIDTH,
             4 * RET_WIDTH + DIFF_WIDTH, 4 * RET_WIDTH + 2 * DIFF_WIDTH]
IN_COLS = 4 * RET_WIDTH + 3 * DIFF_WIDTH

kernel_name = "hybrid_retention_diffattn_macaron_stream_step"


def _rmsnorm(x, g):
    xf = x.astype(jnp.float32)
    y = xf * lax.rsqrt(jnp.mean(xf * xf, axis=-1, keepdims=True) + EPS)
    return (y * g.astype(jnp.float32)).astype(x.dtype)


def _head_layernorm(o, g):
    of = o.astype(jnp.float32)
    mu = jnp.mean(of, axis=-1, keepdims=True)
    var = jnp.mean((of - mu) ** 2, axis=-1, keepdims=True)
    return ((of - mu) * lax.rsqrt(var + EPS) * g.astype(jnp.float32)).astype(o.dtype)


def _swiglu(h, wg, wu, wd):
    return (jax.nn.silu(h @ wg) * (h @ wu)) @ wd


def _rope(x, pos, theta, rot_dim):
    half = rot_dim // 2
    inv = jnp.power(jnp.float32(theta), -jnp.arange(half, dtype=jnp.float32) * (2.0 / rot_dim))
    ang = pos.astype(jnp.float32)[:, None] * inv[None, :]
    ang = ang.reshape((1, x.shape[1]) + (1,) * (x.ndim - 3) + (half,))
    cos, sin = jnp.cos(ang), jnp.sin(ang)
    xf = x.astype(jnp.float32)
    x1, x2, rest = xf[..., :half], xf[..., half:rot_dim], xf[..., rot_dim:]
    out = jnp.concatenate([x1 * cos - x2 * sin, x2 * cos + x1 * sin, rest], axis=-1)
    return out.astype(x.dtype)


def _retention(q, k, v, s0, chunk):
    b, l, h, dk = q.shape
    dv = v.shape[-1]
    n = l // chunk
    log_g = jnp.log(1.0 - jnp.power(2.0, -5.0 - jnp.arange(h, dtype=jnp.float32)))
    idx = jnp.arange(chunk, dtype=jnp.float32)
    rel = idx[:, None] - idx[None, :]
    dmask = jnp.where(rel >= 0, jnp.exp(log_g[:, None, None] * jnp.maximum(rel, 0.0)), 0.0)
    qf = q.astype(jnp.float32).reshape(b, n, chunk, h, dk)
    kf = k.astype(jnp.float32).reshape(b, n, chunk, h, dk)
    vf = v.astype(jnp.float32).reshape(b, n, chunk, h, dv)
    scores = jnp.einsum('bnihd,bnjhd->bnhij', qf, kf) * dmask
    o = jnp.einsum('bnhij,bnjhe->bnihe', scores, vf)
    k_dec = jnp.exp(log_g[None, :] * (chunk - 1.0 - idx)[:, None])
    kv = jnp.einsum('bnjhd,bnjhe->nbhde', kf * k_dec[:, :, None], vf)
    blk_dec = jnp.exp(log_g * chunk)[None, :, None, None]

    def step(s, kv_c):
        return blk_dec * s + kv_c, s

    s_last, s_before = lax.scan(step, s0.astype(jnp.float32), kv)
    q_dec = jnp.exp(log_g[None, :] * (idx + 1.0)[:, None])
    o = o + jnp.einsum('bnihd,nbhde->bnihe', qf * q_dec[:, :, None], s_before)
    return o.reshape(b, l, h, dv).astype(q.dtype), s_last


def _diff_attn(q, k, v, q_pos, k_pos, lam):
    s = jnp.einsum('bqhcd,bkhcd->bhcqk', q, k).astype(jnp.float32) * (DIFF_DK ** -0.5)
    mask = (k_pos[None, :] // CHUNK) <= (q_pos[:, None] // CHUNK)
    s = jnp.where(mask, s, -1e30)
    p = jax.nn.softmax(s, axis=-1)
    a = p[:, :, 0] - lam * p[:, :, 1]
    return jnp.einsum('bhqk,bkhe->bqhe', a.astype(v.dtype), v)


def _layer(x, ret_s0, k_past, v_past, f1_pre, f1_wg, f1_wu, f1_wd, f1_post, mix_pre, w_in,
           ret_g, lq1, lk1, lq2, lk2, diff_g, w_out, mix_post, f2_pre, f2_wg, f2_wu, f2_wd,
           f2_post, lam_init):
    b, l, _ = x.shape
    p_len = k_past.shape[1]
    pos = p_len + jnp.arange(l, dtype=jnp.int32)
    x = x + 0.5 * _rmsnorm(_swiglu(_rmsnorm(x, f1_pre), f1_wg, f1_wu, f1_wd), f1_post)
    h = _rmsnorm(x, mix_pre)
    q_r, k_r, v_r, g_r, q_d, k_d, v_d = jnp.split(h @ w_in, IN_SPLITS, axis=-1)
    q_r = _rope(q_r.reshape(b, l, RET_HEADS, RET_DK), pos, RET_THETA, RET_DK)
    k_r = _rope(k_r.reshape(b, l, RET_HEADS, RET_DK), pos, RET_THETA, RET_DK) * (RET_DK ** -0.5)
    v_r = v_r.reshape(b, l, RET_HEADS, RET_DV)
    ret_o, s_new = _retention(q_r, k_r, v_r, ret_s0, min(CHUNK, l))
    ret_y = jax.nn.silu(g_r) * _head_layernorm(ret_o, ret_g).reshape(b, l, RET_WIDTH)
    q_d = _rope(q_d.reshape(b, l, DIFF_HEADS, 2, DIFF_DK), pos, ROPE_THETA, ROT_DIM)
    k_d = _rope(k_d.reshape(b, l, DIFF_HEADS, 2, DIFF_DK), pos, ROPE_THETA, ROT_DIM)
    v_d = v_d.reshape(b, l, DIFF_HEADS, DIFF_DV)
    lam = (jnp.exp(jnp.sum(lq1.astype(jnp.float32) * lk1.astype(jnp.float32)))
           - jnp.exp(jnp.sum(lq2.astype(jnp.float32) * lk2.astype(jnp.float32))) + lam_init)
    k_all = jnp.concatenate([k_past.astype(k_d.dtype), k_d], axis=1)
    v_all = jnp.concatenate([v_past.astype(v_d.dtype), v_d], axis=1)
    k_pos = jnp.arange(p_len + l, dtype=jnp.int32)
    qb = min(Q_BLOCK, l)
    outs = []
    for blk in range(l // qb):
        end = p_len + (blk + 1) * qb
        outs.append(_diff_attn(q_d[:, blk * qb:(blk + 1) * qb], k_all[:, :end], v_all[:, :end],
                               pos[blk * qb:(blk + 1) * qb], k_pos[:end], lam))
    diff_o = jnp.concatenate(outs, axis=1)
    diff_y = (_rmsnorm(diff_o, diff_g) * (1.0 - lam_init)).reshape(b, l, DIFF_WIDTH)
    y = jnp.concatenate([ret_y, diff_y], axis=-1) @ w_out
    x = x + _rmsnorm(y, mix_post)
    x = x + 0.5 * _rmsnorm(_swiglu(_rmsnorm(x, f2_pre), f2_wg, f2_wu, f2_wd), f2_post)
    return x, s_new, k_d, v_d


def setup_inputs(seed: int = 0) -> dict:
    key = jax.random.key(seed)
    ks = iter(jax.random.split(key, 32))

    def nrm(shape, scale):
        return jax.random.normal(next(ks), shape, jnp.float32) * scale

    def gain(shape):
        return 1.0 + nrm(shape, 0.05)

    return {
        'x_prompt': nrm((BATCH, SEQ, D_MODEL), 1.0),
        'x_sample': nrm((DEC_BATCH, DEC_SEQ, D_MODEL), 1.0),
        'state_ret': nrm((DEPTH, DEC_BATCH, RET_HEADS, RET_DK, RET_DV), 1.0),
        'cache_diff_k': nrm((DEPTH, DEC_BATCH, PAST_LEN, DIFF_HEADS, 2, DIFF_DK), 1.0),
        'cache_diff_v': nrm((DEPTH, DEC_BATCH, PAST_LEN, DIFF_HEADS, DIFF_DV), 1.0),
        'ffn1_pre_g': gain((DEPTH, D_MODEL)),
        'ffn1_w_gate': nrm((DEPTH, D_MODEL, D_FF), D_MODEL ** -0.5),
        'ffn1_w_up': nrm((DEPTH, D_MODEL, D_FF), D_MODEL ** -0.5),
        'ffn1_w_down': nrm((DEPTH, D_FF, D_MODEL), D_FF ** -0.5),
        'ffn1_post_g': gain((DEPTH, D_MODEL)),
        'mix_pre_g': gain((DEPTH, D_MODEL)),
        'w_in': nrm((DEPTH, D_MODEL, IN_COLS), D_MODEL ** -0.5),
        'ret_norm_g': gain((DEPTH, RET_HEADS, RET_DV)),
        'diff_lq1': nrm((DEPTH, DIFF_DK), 0.1),
        'diff_lk1': nrm((DEPTH, DIFF_DK), 0.1),
        'diff_lq2': nrm((DEPTH, DIFF_DK), 0.1),
        'diff_lk2': nrm((DEPTH, DIFF_DK), 0.1),
        'diff_norm_g': gain((DEPTH, DIFF_DV)),
        'w_out': nrm((DEPTH, MIX_WIDTH, D_MODEL), MIX_WIDTH ** -0.5),
        'mix_post_g': gain((DEPTH, D_MODEL)),
        'ffn2_pre_g': gain((DEPTH, D_MODEL)),
        'ffn2_w_gate': nrm((DEPTH, D_MODEL, D_FF), D_MODEL ** -0.5),
        'ffn2_w_up': nrm((DEPTH, D_MODEL, D_FF), D_MODEL ** -0.5),
        'ffn2_w_down': nrm((DEPTH, D_FF, D_MODEL), D_FF ** -0.5),
        'ffn2_post_g': gain((DEPTH, D_MODEL)),
    }


def reference(x_prompt, x_sample, state_ret, cache_diff_k, cache_diff_v,
              ffn1_pre_g, ffn1_w_gate, ffn1_w_up, ffn1_w_down, ffn1_post_g,
              mix_pre_g, w_in, ret_norm_g, diff_lq1, diff_lk1, diff_lq2, diff_lk2,
              diff_norm_g, w_out, mix_post_g,
              ffn2_pre_g, ffn2_w_gate, ffn2_w_up, ffn2_w_down, ffn2_post_g):
    xp, xs = x_prompt, x_sample
    rp, kp, vp, rs, ksm, vsm = [], [], [], [], [], []
    for li in range(DEPTH):
        lam_init = 0.8 - 0.6 * math.exp(-0.3 * li)
        w = (ffn1_pre_g[li], ffn1_w_gate[li], ffn1_w_up[li], ffn1_w_down[li], ffn1_post_g[li],
             mix_pre_g[li], w_in[li], ret_norm_g[li], diff_lq1[li], diff_lk1[li], diff_lq2[li],
             diff_lk2[li], diff_norm_g[li], w_out[li], mix_post_g[li],
             ffn2_pre_g[li], ffn2_w_gate[li], ffn2_w_up[li], ffn2_w_down[li], ffn2_post_g[li])
        s0 = jnp.zeros((xp.shape[0], RET_HEADS, RET_DK, RET_DV), jnp.float32)
        k0 = jnp.zeros((xp.shape[0], 0, DIFF_HEADS, 2, DIFF_DK), xp.dtype)
        v0 = jnp.zeros((xp.shape[0], 0, DIFF_HEADS, DIFF_DV), xp.dtype)
        xp, s_p, k_p, v_p = _layer(xp, s0, k0, v0, *w, lam_init)
        xs, s_s, k_s, v_s = _layer(xs, state_ret[li].astype(jnp.float32), cache_diff_k[li],
                                   cache_diff_v[li], *w, lam_init)
        rp.append(s_p.astype(xp.dtype)); kp.append(k_p); vp.append(v_p)
        rs.append(s_s.astype(state_ret.dtype)); ksm.append(k_s); vsm.append(v_s)
    return (xp, xs, jnp.stack(rp), jnp.stack(kp), jnp.stack(vp),
            jnp.stack(rs), jnp.stack(ksm), jnp.stack(vsm))
```

```cpp
#include <hip/hip_runtime.h>
#include <hip/hip_cooperative_groups.h>
#include <cstdio>
#include <cstdint>
namespace cg = cooperative_groups;

#define LAS __attribute__((address_space(3)))
typedef unsigned short bf16_t;
typedef short bf16x8 __attribute__((ext_vector_type(8)));
typedef short s16x4 __attribute__((ext_vector_type(4)));
typedef float f32x4 __attribute__((ext_vector_type(4)));
typedef float f32x16 __attribute__((ext_vector_type(16)));
typedef unsigned u32x4 __attribute__((ext_vector_type(4)));
typedef unsigned u32x2 __attribute__((ext_vector_type(2)));
typedef LAS unsigned char lds_t;

constexpr int DM = 1024, TP = 32768, TS = 512, T = TP + TS, DFF = 2816, NIN = 3584;
constexpr int SEQ = 4096, PAST = 4096, DSEQ = 64;
constexpr float EPS = 1e-6f;
constexpr float QSCALE = 0.125f * 1.4426950408889634f;
constexpr float KRSCALE = 0.08838834764831845f;
constexpr float LAM_INIT = 0.2f;
constexpr size_t OY = 0, ORET_P = 34078720, OK_P = 34603008, OV_P = 51380224, ORET_S = 68157440, OK_S = 68681728, OV_S = 68943872;
constexpr size_t MiB = 1u << 20;
constexpr size_t WS_CTL = 0, WS_RT = 1 * MiB, WS_DT = 3 * MiB + 512 * 1024, WS_WGU1 = 4 * MiB, WS_WD1 = 15 * MiB, WS_WIN = 21 * MiB, WS_WOUT = 28 * MiB,
                 WS_WGU2 = 30 * MiB, WS_WD2 = 41 * MiB, WS_H = 47 * MiB, WS_D = 112 * MiB, WS_KC = 177 * MiB, WS_VC = 209 * MiB, WS_BIG = 241 * MiB, WS_PART = 470 * MiB, WS_SLOT = 496 * MiB;
constexpr int NPOS = 4160;
constexpr int LDS_BYTES = 147456;
constexpr int LDS_MISC = 131072;
constexpr int LDS_TAB = LDS_MISC + 256;
constexpr int CW_CNT = 1024, CW_CNT_EX = 8192;
#ifndef EPI_RT
#define EPI_RT 1
#endif
#ifndef EPI_DT
#define EPI_DT 1
#endif
#ifndef EPI_F32
#define EPI_F32 1
#endif
#ifndef SKIP_ATTN
#define SKIP_ATTN 0
#endif
#ifndef KV_TEST
#define KV_TEST 0
#endif
#ifndef REP_KVONLY
#define REP_KVONLY 0
#endif
#ifndef PH_MASK
#define PH_MASK 0xFFFF
#endif
#ifndef REP_MASK
#define REP_MASK 0
#endif
#define XSYNC() xcd_barrier(xbar)
#define PH(k) for (int rep_ = 0; rep_ < 1 + ((REP_MASK >> (k)) & 1); ++rep_) if (rep_ == 0 || grid_sync_fn(grid)) if constexpr ((PH_MASK >> (k)) & 1)
#define GRID_SYNC() do { asm volatile("s_waitcnt vmcnt(0) lgkmcnt(0)" ::: "memory"); __builtin_amdgcn_fence(__ATOMIC_RELEASE, "workgroup"); grid.sync(); } while (0)

typedef float f32x2_t __attribute__((ext_vector_type(2))); typedef __bf16 bf16x2_t __attribute__((ext_vector_type(2)));
__device__ __forceinline__ unsigned cvt_pk_bf16(float lo, float hi) { const f32x2_t v = {lo, hi}; const bf16x2_t b = __builtin_convertvector(v, bf16x2_t); return __builtin_bit_cast(unsigned, b); }
__device__ __forceinline__ float bf_lo(unsigned w) { return __uint_as_float(w << 16); }
__device__ __forceinline__ float bf_hi(unsigned w) { return __uint_as_float(w & 0xffff0000u); }
__device__ __forceinline__ float bf1(bf16_t b) { return __uint_as_float(((unsigned)b) << 16); }
__device__ __forceinline__ bf16_t f2bf(float f) { return (bf16_t)(cvt_pk_bf16(f, 0.f) & 0xffffu); }
__device__ __forceinline__ float wave_sum(float v) {
#pragma unroll
    for (int o = 1; o < 64; o <<= 1) v += __shfl_xor(v, o);
    return v;
}
__device__ __forceinline__ float half_swap_sum(float v) { auto rr = __builtin_amdgcn_permlane32_swap(__float_as_uint(v), __float_as_uint(v), false, false); return __uint_as_float(rr[0]) + __uint_as_float(rr[1]); }
__device__ __forceinline__ float half_swap_max(float v) { auto rr = __builtin_amdgcn_permlane32_swap(__float_as_uint(v), __float_as_uint(v), false, false); return fmaxf(__uint_as_float(rr[0]), __uint_as_float(rr[1])); }
__device__ __forceinline__ int fresh_tid() { int t = threadIdx.x; asm volatile("" : "+v"(t)); return t; }
__device__ __forceinline__ float max3f(float a, float b, float c) { float r; asm("v_max3_f32 %0, %1, %2, %3" : "=v"(r) : "v"(a), "v"(b), "v"(c)); return r; }
__device__ __forceinline__ int crow(int r, int hi) { return (r & 3) + 8 * (r >> 2) + 4 * hi; }
__device__ __forceinline__ float fast_silu(float g) { return g * __builtin_amdgcn_rcpf(1.0f + __builtin_amdgcn_exp2f(-1.4426950408889634f * g)); }
__device__ __forceinline__ s16x4 tr_read(const lds_t* p) { typedef short v4i16_t __attribute__((ext_vector_type(4))); return __builtin_bit_cast(s16x4, __builtin_amdgcn_ds_read_tr16_b64_v4i16((LAS v4i16_t*)p)); }
template <int SO> __device__ __forceinline__ bf16x8 tr_frag(const lds_t* a, int pitch) {
    const s16x4 lo = tr_read(a), h4 = tr_read(a + SO * pitch);
    return (bf16x8){lo[0], lo[1], lo[2], lo[3], h4[0], h4[1], h4[2], h4[3]};
}
__device__ __forceinline__ int tr_lane_off(int lane, int HM, int pitch) { return (HM * (lane >> 5) + ((lane & 15) >> 2)) * pitch + (16 * ((lane >> 4) & 1) + 4 * (lane & 3)) * 2; }
__device__ __forceinline__ bf16x8 pack8(float a0, float a1, float a2, float a3, float a4, float a5, float a6, float a7) {
    u32x4 w; w.x = cvt_pk_bf16(a0, a1); w.y = cvt_pk_bf16(a2, a3); w.z = cvt_pk_bf16(a4, a5); w.w = cvt_pk_bf16(a6, a7); return __builtin_bit_cast(bf16x8, w);
}
#define MFMA32(a, b, c) __builtin_amdgcn_mfma_f32_32x32x16_bf16((a), (b), (c), 0, 0, 0)

namespace pg8 {
constexpr int BM = 256, BK = 64, HALF = 128, HTB = HALF * BK * 2, STAGE_BYTES = 8 * HTB, NXCD = 8, WGM = 8;
__host__ __device__ __forceinline__ int lds_byte(int r, int c) { const int st = (r >> 4) * 2 + (c >> 5), rr = r & 15, cc = c & 31, ob = rr * 64 + cc * 2; return st * 1024 + (ob ^ (((ob >> 9) & 1) << 5)); }
__host__ __device__ __forceinline__ void stage_rc(int b, int& R, int& C) { const int st = b / 1024, sb = b % 1024, swz = sb ^ (((sb >> 9) & 1) << 5); R = (st >> 1) * 16 + swz / 64; C = (st & 1) * 32 + (swz % 64) / 2; }
__host__ __device__ __forceinline__ int perm32(int rho) { const int n = rho >> 4, i = rho & 15; return 8 * (i >> 2) + 4 * n + (i & 3); }
struct Unit { int pm, pn, kc; };
struct Gemm { const bf16_t* A; const bf16_t* Bt; int M, N, K, KL; };
struct StaticOrder {
    int nM, nN, nwg, G, c;
    __device__ void init(int M, int N, int G_, int c_) { nM = M / BM; nN = N / BM; nwg = nM * nN; G = G_; c = c_; }
    __device__ bool next(int i, Unit& u) const {
        const long L = (long)i * G + c; if (L >= nwg) return false;
        int wgid = (int)L; { const int q = nwg / NXCD, r = nwg % NXCD, xcd = wgid % NXCD, off = wgid / NXCD; wgid = (xcd < r ? xcd * (q + 1) : r * (q + 1) + (xcd - r) * q) + off; }
        const int nig = WGM * nN, gid = wgid / nig, fm = gid * WGM, gsz = (nM - fm) < WGM ? (nM - fm) : WGM;
        u.pm = fm + ((wgid % nig) % gsz); u.pn = (wgid % nig) / gsz; u.kc = 0; return true;
    }
};
struct SplitOrder {
    int nM, nN, nK, G, c;
    __device__ void init(int M, int N, int nK_, int G_, int c_) { nM = M / BM; nN = N / BM; nK = nK_; G = G_; c = c_; }
    __device__ bool next(int i, Unit& u) const {
        const int L = i * G + c; if (L >= nM * nN * nK) return false;
        u.kc = L % nK; const int t = L / nK; u.pn = t % nN; u.pm = t / nN; return true;
    }
};
struct Order4 {
    int nM, G, c;
    __device__ void init(int M, int G_, int c_) { nM = M / BM; G = G_; c = c_; }
    __device__ bool next(int i, Unit& u) const {
        if ((G & 31) == 0) { const int per = G >> 2, x = c & 7, j = c >> 3; u.pm = i * per + x * (per >> 3) + (j >> 2); u.pn = j & 3; }
        else { const int L = i * G + c; u.pm = L >> 2; u.pn = L & 3; }
        u.kc = 0; return u.pm < nM;
    }
};
template <class Epi, class Sched>
__device__ __forceinline__ void gemm_phase(lds_t* lds, const Gemm g, const Sched& S, const Epi& E) {
    int tid = threadIdx.x; asm volatile("" : "+v"(tid));
    const int wid = __builtin_amdgcn_readfirstlane(tid >> 6), lane = tid & 63, wr = wid >> 2, wc = wid & 3, fr = lane & 15, fq = lane >> 4;
    const int K = g.K, nt = g.KL / BK;
    const size_t kcstep = (size_t)g.KL * 2;
    unsigned voffA[2], voffB[2];
#pragma unroll
    for (int i = 0; i < 2; ++i) { int R, C; stage_rc(tid * 16 + i * 8192, R, C); const int Rb = (R & ~31) + perm32(R & 31);
        voffA[i] = (unsigned)(R * K + C) * 2u; voffB[i] = (unsigned)(Rb * K + C) * 2u; }
    const size_t kstep = (size_t)(BK * 2);
    const size_t hstep = (size_t)HALF * K * 2;
    const size_t tstep = 2 * hstep;
    const unsigned ldsw = (unsigned)wid * 1024u;
    const int aoff = lds_byte(wr * 64 + fr, fq * 8), boff = lds_byte(wc * 32 + fr, fq * 8);
#define PG8_SA(b, h) (((b) * 2 + (h)) * HTB)
#define PG8_SB(b, h) ((4 + (b) * 2 + (h)) * HTB)
#define PG8_STAGE(bufoff, gbase, voff) do { _Pragma("unroll") for (int _i = 0; _i < 2; ++_i) \
        __builtin_amdgcn_global_load_lds((const unsigned*)((const char*)(gbase) + (voff)[_i]), (LAS unsigned*)(lds + (bufoff) + ldsw + _i * 8192), 16, 0, 0); } while (0)
#define PG8_LDA(dst, b, h) do { _Pragma("unroll") for (int m = 0; m < 4; ++m) _Pragma("unroll") for (int k = 0; k < 2; ++k) dst[m][k] = *(const LAS bf16x8*)(lds + PG8_SA(b, h) + aoff + m * 2048 + k * 1024); } while (0)
#define PG8_LDB(dst, b, h) do { _Pragma("unroll") for (int n = 0; n < 2; ++n) _Pragma("unroll") for (int k = 0; k < 2; ++k) dst[n][k] = *(const LAS bf16x8*)(lds + PG8_SB(b, h) + boff + n * 2048 + k * 1024); } while (0)
#define PG8_MMA(ai, bj, At, Bt) do { __builtin_amdgcn_s_setprio(1); _Pragma("unroll") for (int m = 0; m < 4; ++m) _Pragma("unroll") for (int n = 0; n < 2; ++n) _Pragma("unroll") for (int k = 0; k < 2; ++k) \
        acc[ai][bj][m][n] = __builtin_amdgcn_mfma_f32_16x16x32_bf16(Bt[n][k], At[m][k], acc[ai][bj][m][n], 0, 0, 0); __builtin_amdgcn_s_setprio(0); } while (0)
#define PG8_WAIT_V(n) asm volatile("s_waitcnt vmcnt(" #n ")" ::: "memory")
#define PG8_WAIT_L(n) asm volatile("s_waitcnt lgkmcnt(" #n ")" ::: "memory")
#define PG8_BAR __builtin_amdgcn_s_barrier()
#define PG8_SCHED __builtin_amdgcn_sched_barrier(0)
    Unit cur, nxt; int ui = 0;
    if (!S.next(0, cur)) return;
    f32x4 acc[2][2][4][2];
#pragma unroll
    for (int a = 0; a < 2; ++a)
#pragma unroll
        for (int b = 0; b < 2; ++b)
#pragma unroll
            for (int m = 0; m < 4; ++m)
#pragma unroll
                for (int n = 0; n < 2; ++n) acc[a][b][m][n] = (f32x4){0.f, 0.f, 0.f, 0.f};
    bf16x8 At[4][2], B0[2][2], B1[2][2];
    const char* cA = (const char*)g.A + (size_t)cur.pm * tstep + (size_t)cur.kc * kcstep; const char* cB = (const char*)g.Bt + (size_t)cur.pn * tstep + (size_t)cur.kc * kcstep;
    PG8_STAGE(PG8_SB(0, 0), cB, voffB); PG8_STAGE(PG8_SB(0, 1), cB + hstep, voffB); PG8_STAGE(PG8_SA(0, 0), cA, voffA); PG8_STAGE(PG8_SA(0, 1), cA + hstep, voffA);
    if (wr == 1) PG8_BAR;
    PG8_WAIT_V(2); PG8_BAR;
    PG8_STAGE(PG8_SB(1, 0), cB + kstep, voffB); PG8_STAGE(PG8_SA(1, 0), cA + kstep, voffA); PG8_STAGE(PG8_SB(1, 1), cB + hstep + kstep, voffB);
    PG8_WAIT_V(6); PG8_BAR;
    for (;;) {
        const bool has_next = S.next(ui + 1, nxt);
        const char* nA = has_next ? (const char*)g.A + (size_t)nxt.pm * tstep + (size_t)nxt.kc * kcstep : cA; const char* nB = has_next ? (const char*)g.Bt + (size_t)nxt.pn * tstep + (size_t)nxt.kc * kcstep : cB;
        for (int t = 0; t < nt; t += 2) {
            const bool last = (t == nt - 2);
            const char* a1 = cA + (size_t)(t + 1) * kstep;
            const char* a2 = last ? nA : cA + (size_t)(t + 2) * kstep; const char* b2 = last ? nB : cB + (size_t)(t + 2) * kstep;
            const char* a3 = a2 + kstep; const char* b3 = b2 + kstep;
            PG8_LDB(B0, 0, 0); PG8_LDB(B1, 0, 1); PG8_SCHED; PG8_LDA(At, 0, 0); PG8_STAGE(PG8_SA(1, 1), a1 + hstep, voffA);
            PG8_WAIT_V(8); PG8_WAIT_L(0); PG8_BAR; PG8_MMA(0, 0, At, B0); PG8_MMA(0, 1, At, B1); PG8_BAR; PG8_SCHED;
            PG8_LDA(At, 0, 1); PG8_STAGE(PG8_SB(0, 0), b2, voffB); PG8_STAGE(PG8_SB(0, 1), b2 + hstep, voffB); PG8_STAGE(PG8_SA(0, 0), a2, voffA);
            PG8_WAIT_V(8); PG8_WAIT_L(0); PG8_BAR; PG8_MMA(1, 0, At, B0); PG8_MMA(1, 1, At, B1); PG8_BAR; PG8_SCHED;
            PG8_LDB(B0, 1, 0); PG8_LDB(B1, 1, 1); PG8_SCHED; PG8_LDA(At, 1, 0); PG8_STAGE(PG8_SA(0, 1), a2 + hstep, voffA);
            PG8_WAIT_V(8); PG8_WAIT_L(0); PG8_BAR; PG8_MMA(0, 0, At, B0); PG8_MMA(0, 1, At, B1); PG8_BAR; PG8_SCHED;
            PG8_LDA(At, 1, 1); PG8_STAGE(PG8_SB(1, 0), b3, voffB); PG8_STAGE(PG8_SB(1, 1), b3 + hstep, voffB); PG8_STAGE(PG8_SA(1, 0), a3, voffA);
            PG8_WAIT_V(8); PG8_WAIT_L(0); PG8_BAR; PG8_MMA(1, 0, At, B0); PG8_MMA(1, 1, At, B1); PG8_BAR; PG8_SCHED;
        }
        if (wr == 0) PG8_BAR;
        PG8_SCHED; asm volatile("" ::: "memory"); E(acc, cur, wr, wc, fr, fq); asm volatile("" ::: "memory"); PG8_SCHED;
        if (!has_next) break;
#pragma unroll
        for (int a = 0; a < 2; ++a)
#pragma unroll
            for (int b = 0; b < 2; ++b)
#pragma unroll
                for (int m = 0; m < 4; ++m)
#pragma unroll
                    for (int n = 0; n < 2; ++n) acc[a][b][m][n] = (f32x4){0.f, 0.f, 0.f, 0.f};
        cur = nxt; cA = nA; cB = nB; ++ui;
        if (wr == 1) PG8_BAR;
    }
    PG8_WAIT_V(0);
    PG8_BAR;
#undef PG8_SA
#undef PG8_SB
#undef PG8_STAGE
#undef PG8_LDA
#undef PG8_LDB
#undef PG8_MMA
#undef PG8_WAIT_V
#undef PG8_WAIT_L
#undef PG8_BAR
#undef PG8_SCHED
}
}

struct EpiSwiglu {
    bf16_t* O;
    __device__ __forceinline__ void operator()(const f32x4 (&acc)[2][2][4][2], const pg8::Unit& u, int wr, int wc, int fr, int fq) const {
        const int row0 = u.pm * 256 + wr * 64 + fr, col0 = u.pn * 128 + wc * 32 + 8 * fq;
#pragma unroll
        for (int ai = 0; ai < 2; ++ai)
#pragma unroll
            for (int m = 0; m < 4; ++m) {
                bf16_t* rowp = O + (size_t)(row0 + ai * 128 + m * 16) * DFF + col0;
                const f32x4 g0 = acc[ai][0][m][0], g1 = acc[ai][0][m][1], u0 = acc[ai][1][m][0], u1 = acc[ai][1][m][1];
                u32x4 w;
                w.x = cvt_pk_bf16(fast_silu(g0[0]) * u0[0], fast_silu(g0[1]) * u0[1]); w.y = cvt_pk_bf16(fast_silu(g0[2]) * u0[2], fast_silu(g0[3]) * u0[3]);
                w.z = cvt_pk_bf16(fast_silu(g1[0]) * u1[0], fast_silu(g1[1]) * u1[1]); w.w = cvt_pk_bf16(fast_silu(g1[2]) * u1[2], fast_silu(g1[3]) * u1[3]);
                *(u32x4*)rowp = w;
            }
    }
};
struct EpiD {
    bf16_t* O;
    __device__ __forceinline__ void operator()(const f32x4 (&acc)[2][2][4][2], const pg8::Unit& u, int wr, int wc, int fr, int fq) const {
        const int row0 = u.pm * 256 + wr * 64 + fr, col0 = u.pn * 256 + wc * 32 + 8 * fq;
#pragma unroll
        for (int ai = 0; ai < 2; ++ai)
#pragma unroll
            for (int m = 0; m < 4; ++m) {
                bf16_t* rowp = O + (size_t)(row0 + ai * 128 + m * 16) * DM + col0;
#pragma unroll
                for (int bj = 0; bj < 2; ++bj) { const f32x4 v0 = acc[ai][bj][m][0], v1 = acc[ai][bj][m][1];
                    u32x4 w; w.x = cvt_pk_bf16(v0[0], v0[1]); w.y = cvt_pk_bf16(v0[2], v0[3]); w.z = cvt_pk_bf16(v1[0], v1[1]); w.w = cvt_pk_bf16(v1[2], v1[3]);
                    *(u32x4*)(rowp + bj * 128) = w; }
            }
    }
};
struct RowStat { float* slots; unsigned* cnt; };
#define RLX_AGENT __ATOMIC_RELAXED, __HIP_MEMORY_SCOPE_AGENT
__device__ __forceinline__ void rowstat_exchange(const f32x4 (&v)[2][2][4][2], const RowStat& st, int pm, int pn, lds_t* tab, int wr, int wc, int fr, int fq, int tid, int wid, int lane) {
    LAS float* Pt = (LAS float*)tab;
    LAS float* St = (LAS float*)(tab + 4096);
#pragma unroll
    for (int ai = 0; ai < 2; ++ai)
#pragma unroll
        for (int m = 0; m < 4; ++m) {
            float s = 0.f;
#pragma unroll
            for (int bj = 0; bj < 2; ++bj)
#pragma unroll
                for (int n = 0; n < 2; ++n) { const f32x4 x = v[ai][bj][m][n]; s += (x[0] * x[0] + x[1] * x[1]) + (x[2] * x[2] + x[3] * x[3]); }
            s += __shfl_xor(s, 16); s += __shfl_xor(s, 32);
            if (fq == 0) Pt[(ai * 128 + wr * 64 + m * 16 + fr) * 4 + wc] = s;
        }
    asm volatile("s_waitcnt lgkmcnt(0)" ::: "memory"); __builtin_amdgcn_s_barrier(); asm volatile("" ::: "memory");
    if (tid < 256) {
        const float tot = (Pt[tid * 4 + 0] + Pt[tid * 4 + 1]) + (Pt[tid * 4 + 2] + Pt[tid * 4 + 3]);
        __hip_atomic_store((unsigned*)(st.slots + ((size_t)pm * 256 + tid) * 4 + pn), __float_as_uint(tot), RLX_AGENT);
    }
    asm volatile("s_waitcnt vmcnt(0)" ::: "memory");
    if (wid < 4 && lane == 0) __hip_atomic_fetch_add(st.cnt + 64 * pm, 1u, RLX_AGENT);
    if (wid == 0) {
        unsigned spins = 0;
        while ((unsigned)__builtin_amdgcn_readfirstlane(__hip_atomic_load(st.cnt + 64 * pm, RLX_AGENT)) < 16u) { __builtin_amdgcn_s_sleep(2); if (++spins > 400000u) break; }
        __builtin_amdgcn_fence(__ATOMIC_ACQUIRE, "agent");
    }
    asm volatile("s_waitcnt vmcnt(0) lgkmcnt(0)" ::: "memory"); __builtin_amdgcn_s_barrier(); asm volatile("" ::: "memory");
    if (tid < 256) {
        const unsigned* sl = (const unsigned*)(st.slots + ((size_t)pm * 256 + tid) * 4);
        const float t = (__uint_as_float(__hip_atomic_load(sl + 0, RLX_AGENT)) + __uint_as_float(__hip_atomic_load(sl + 1, RLX_AGENT))) +
                        (__uint_as_float(__hip_atomic_load(sl + 2, RLX_AGENT)) + __uint_as_float(__hip_atomic_load(sl + 3, RLX_AGENT)));
        St[tid] = __builtin_amdgcn_rsqf(t * (1.0f / DM) + EPS);
    }
    asm volatile("s_waitcnt vmcnt(0) lgkmcnt(0)" ::: "memory"); __builtin_amdgcn_s_barrier(); asm volatile("" ::: "memory");
}
template <bool SRC_BF, int GB>
__device__ __forceinline__ void load_xbatch(const void* xs_, size_t off0, int g0, u32x4 (&xb)[4][2], f32x4 (&xf)[2][2][2]) {
#pragma unroll
    for (int k = 0; k < GB; ++k) { const int gg = g0 + k; const size_t o_ = off0 + (size_t)((gg >> 2) * 128 + (gg & 3) * 16) * DM;
#pragma unroll
        for (int bj = 0; bj < 2; ++bj) {
            if (SRC_BF) xb[k][bj] = *(const u32x4*)((const bf16_t*)xs_ + o_ + bj * 128);
            else { xf[k & 1][bj][0] = *(const f32x4*)((const float*)xs_ + o_ + bj * 128); xf[k & 1][bj][1] = *(const f32x4*)((const float*)xs_ + o_ + bj * 128 + 4); }
        } }
}
template <bool SRC_BF, bool DST_BF>
struct EpiResNorm {
    const void* xsrc; void* X; bf16_t* H; const float* gpost; const float* gpre; float scale; RowStat st1, st2; lds_t* lds;
    __device__ __forceinline__ void operator()(f32x4 (&acc)[2][2][4][2], const pg8::Unit& u, int wr, int wc, int fr, int fq) const {
        const int tid = fresh_tid(), lane = tid & 63, wid = __builtin_amdgcn_readfirstlane(tid >> 6);
        const int cb = u.pn * 256 + wc * 32 + 8 * fq;
        const size_t off0 = (size_t)(u.pm * 256 + wr * 64 + fr) * DM + cb;
        constexpr int GB = SRC_BF ? 4 : 2;
        u32x4 xb[4][2]; f32x4 xf[2][2][2];
        f32x4 g[2][2];
        float sc1_ = scale; asm volatile("" : "+v"(sc1_)); const f32x4 scv = {sc1_, sc1_, sc1_, sc1_};
#pragma unroll
        for (int bj = 0; bj < 2; ++bj)
#pragma unroll
            for (int n = 0; n < 2; ++n) g[bj][n] = *(const f32x4*)(gpost + cb + bj * 128 + 4 * n) * scv;
        load_xbatch<SRC_BF, GB>(xsrc, off0, 0, xb, xf);
        rowstat_exchange(acc, st1, u.pm, u.pn, lds + LDS_TAB, wr, wc, fr, fq, tid, wid, lane);
        const LAS float* St = (const LAS float*)(lds + LDS_TAB + 4096);
#pragma unroll
        for (int gq = 0; gq < 8; ++gq) {
            const int ai = gq >> 2, m = gq & 3, k = gq % GB;
            if (gq != 0 && k == 0) load_xbatch<SRC_BF, GB>(xsrc, off0, gq, xb, xf);
            const int rl = ai * 128 + wr * 64 + m * 16 + fr; const float rs = St[rl];
            const size_t off = off0 + (size_t)(ai * 128 + m * 16) * DM;
#pragma unroll
            for (int bj = 0; bj < 2; ++bj) {
                f32x4 x0, x1;
                if (SRC_BF) { const u32x4 w = xb[k][bj];
                    x0 = (f32x4){bf_lo(w.x), bf_hi(w.x), bf_lo(w.y), bf_hi(w.y)}; x1 = (f32x4){bf_lo(w.z), bf_hi(w.z), bf_lo(w.w), bf_hi(w.w)}; }
                else { x0 = xf[k & 1][bj][0]; x1 = xf[k & 1][bj][1]; }
                x0 = x0 + acc[ai][bj][m][0] * g[bj][0] * rs; x1 = x1 + acc[ai][bj][m][1] * g[bj][1] * rs;
                acc[ai][bj][m][0] = x0; acc[ai][bj][m][1] = x1;
                if (DST_BF) { u32x4 w; w.x = cvt_pk_bf16(x0[0], x0[1]); w.y = cvt_pk_bf16(x0[2], x0[3]); w.z = cvt_pk_bf16(x1[0], x1[1]); w.w = cvt_pk_bf16(x1[2], x1[3]);
                    *(u32x4*)((bf16_t*)X + off + bj * 128) = w; }
                else { *(f32x4*)((float*)X + off + bj * 128) = x0; *(f32x4*)((float*)X + off + bj * 128 + 4) = x1; }
            }
        }
        if (H) {
            rowstat_exchange(acc, st2, u.pm, u.pn, lds + LDS_TAB + 5120, wr, wc, fr, fq, tid, wid, lane);
            const LAS float* S2 = (const LAS float*)(lds + LDS_TAB + 5120 + 4096);
#pragma unroll
            for (int bj = 0; bj < 2; ++bj)
#pragma unroll
                for (int n = 0; n < 2; ++n) g[bj][n] = *(const f32x4*)(gpre + cb + bj * 128 + 4 * n);
#pragma unroll
            for (int ai = 0; ai < 2; ++ai)
#pragma unroll
                for (int m = 0; m < 4; ++m) {
                    const int rl = ai * 128 + wr * 64 + m * 16 + fr; const float rs = S2[rl];
                    bf16_t* hp = H + (size_t)(u.pm * 256 + rl) * DM + cb;
#pragma unroll
                    for (int bj = 0; bj < 2; ++bj) { const f32x4 h0 = acc[ai][bj][m][0] * g[bj][0] * rs, h1 = acc[ai][bj][m][1] * g[bj][1] * rs;
                        u32x4 w; w.x = cvt_pk_bf16(h0[0], h0[1]); w.y = cvt_pk_bf16(h0[2], h0[3]); w.z = cvt_pk_bf16(h1[0], h1[1]); w.w = cvt_pk_bf16(h1[2], h1[3]);
                        *(u32x4*)(hp + bj * 128) = w; }
                }
        }
    }
};
struct EpiPart {
    float* O;
    __device__ __forceinline__ void operator()(const f32x4 (&acc)[2][2][4][2], const pg8::Unit& u, int wr, int wc, int fr, int fq) const {
        const int row0 = u.pm * 256 + wr * 64 + fr, col0 = u.pn * 256 + wc * 32 + 8 * fq;
        float* base = O + (size_t)u.kc * TS * DM;
#pragma unroll
        for (int ai = 0; ai < 2; ++ai)
#pragma unroll
            for (int m = 0; m < 4; ++m) {
                float* rowp = base + (size_t)(row0 + ai * 128 + m * 16) * DM + col0;
#pragma unroll
                for (int bj = 0; bj < 2; ++bj) { *(f32x4*)(rowp + bj * 128) = acc[ai][bj][m][0]; *(f32x4*)(rowp + bj * 128 + 4) = acc[ai][bj][m][1]; }
            }
    }
};
__device__ __forceinline__ int win_srccol(int nd) {
    const int pn = nd >> 8, dc = nd & 255, sec = pn >> 1, base = sec * 512 + (pn & 1) * 256, bj = dc >> 7, wc = (dc >> 5) & 3, w = dc & 31;
    if (sec == 0 || sec == 1) return base + 128 * (wc >> 1) + 64 * bj + 32 * (wc & 1) + w;
    if (sec == 4 || sec == 5) { const int dim = (w < 8) ? (bj * 8 + w) : (16 + 24 * bj + (w - 8)); return base + 64 * wc + dim; }
    return base + dc;
}
struct EpiIn {
    bf16_t* P; float* out; const float* RT; const float* DT;
    __device__ __forceinline__ void operator()(const f32x4 (&acc)[2][2][4][2], const pg8::Unit& u, int wr, int wc, int fr, int fq) const {
        const int sec = u.pn >> 1, base = sec * 512 + (u.pn & 1) * 256;
        const int row0 = u.pm * 256 + wr * 64 + fr;
        int c0, c1, toff;
        const float* tab; int tstride;
        bool rot;
        if (sec == 0 || sec == 1) { c0 = base + 128 * (wc >> 1) + 32 * (wc & 1) + 8 * fq; c1 = c0 + 64; tab = RT; tstride = 128; toff = (32 * (wc & 1) + 8 * fq) * 2; rot = true; }
        else if (sec == 4 || sec == 5) { if (fq == 0) { c0 = base + 64 * wc; c1 = c0 + 8; } else { c0 = base + 64 * wc + 8 + 8 * fq; c1 = c0 + 24; } tab = RT; tstride = 16; toff = (int)((WS_DT - WS_RT) / 4); rot = (fq == 0); }
        else { c0 = base + 32 * wc + 8 * fq; c1 = c0 + 128; tab = RT; tstride = 0; toff = 0; rot = false; }
        const float sc = sec == 1 ? KRSCALE : (sec == 4 ? QSCALE : 1.0f);
        const bool f32o = sec >= 5;
        const int oc0 = c0 - sec * 512, oc1 = c1 - sec * 512;
        f32x4 cur[4], nx1[4], dlt[4];
        auto load_tab = [&](int pos, f32x4 (&tv)[4]) {
            const f32x4* tp = (const f32x4*)(tab + (size_t)pos * tstride + toff);
            tv[0] = tp[0]; tv[1] = tp[1]; tv[2] = tp[2]; tv[3] = tp[3];
        };
        if (rot) {
            const int r_a = row0, r_b = row0 + 128;
            load_tab(r_a < TP ? (r_a & (SEQ - 1)) : PAST + ((r_a - TP) & (DSEQ - 1)), cur);
            load_tab(r_b < TP ? (r_b & (SEQ - 1)) : PAST + ((r_b - TP) & (DSEQ - 1)), nx1);
            load_tab(16, dlt);
        }
#pragma unroll
        for (int g = 0; g < 8; ++g) {
            const int ai = g >> 2, m = g & 3;
            if (rot) {
                if (g == 4) {
#pragma unroll
                    for (int k = 0; k < 4; ++k) cur[k] = nx1[k];
                } else if (m != 0) {
#pragma unroll
                    for (int k = 0; k < 4; ++k) { const f32x4 cs = cur[k], d = dlt[k];
                        cur[k] = (f32x4){cs[0] * d[0] - cs[1] * d[1], cs[1] * d[0] + cs[0] * d[1], cs[2] * d[2] - cs[3] * d[3], cs[3] * d[2] + cs[2] * d[3]}; }
                }
            }
            f32x4 tv[4];
#pragma unroll
            for (int k = 0; k < 4; ++k) tv[k] = cur[k];
            const int row = row0 + ai * 128 + m * 16;
            bf16_t* rowp = P + (size_t)row * NIN;
            float* ob = out + (sec == 5 ? (row < TP ? OK_P : OK_S) : (row < TP ? OV_P : OV_S)) + (size_t)(row < TP ? row : row - TP) * 512;
            u32x4 wa, wb;
#pragma unroll
            for (int n = 0; n < 2; ++n) {
                f32x4 a = acc[ai][0][m][n], b = acc[ai][1][m][n];
                if (rot) {
                    const f32x4 t0 = tv[2 * n], t1 = tv[2 * n + 1];
                    f32x4 x, y;
                    x[0] = a[0] * t0[0] - b[0] * t0[1]; y[0] = b[0] * t0[0] + a[0] * t0[1];
                    x[1] = a[1] * t0[2] - b[1] * t0[3]; y[1] = b[1] * t0[2] + a[1] * t0[3];
                    x[2] = a[2] * t1[0] - b[2] * t1[1]; y[2] = b[2] * t1[0] + a[2] * t1[1];
                    x[3] = a[3] * t1[2] - b[3] * t1[3]; y[3] = b[3] * t1[2] + a[3] * t1[3];
                    a = x; b = y;
                }
                if (f32o) { *(f32x4*)(ob + oc0 + 4 * n) = a; *(f32x4*)(ob + oc1 + 4 * n) = b; }
                a *= sc; b *= sc;
                if (n == 0) { wa.x = cvt_pk_bf16(a[0], a[1]); wa.y = cvt_pk_bf16(a[2], a[3]); wb.x = cvt_pk_bf16(b[0], b[1]); wb.y = cvt_pk_bf16(b[2], b[3]); }
                else { wa.z = cvt_pk_bf16(a[0], a[1]); wa.w = cvt_pk_bf16(a[2], a[3]); wb.z = cvt_pk_bf16(b[0], b[1]); wb.w = cvt_pk_bf16(b[2], b[3]); }
            }
            *(u32x4*)(rowp + c0) = wa; *(u32x4*)(rowp + c1) = wb;
        }
    }
};

struct Params { const float* in[25]; float* out; unsigned char* ws; };

template <class F>
__device__ __forceinline__ void transpose_item(const float* W, int K, int Nsrc, bf16_t* WT, LAS float* scr, int k0, int n0, int lane, F srccol) {
    const int sc = srccol(n0 + (lane & 31));
#pragma unroll
    for (int i = 0; i < 32; ++i) { const int kk = 2 * i + (lane >> 5); scr[kk * 33 + (lane & 31)] = W[(size_t)(k0 + kk) * Nsrc + sc]; }
    asm volatile("s_waitcnt lgkmcnt(0)" ::: "memory");
    const int c = lane & 7;
#pragma unroll
    for (int j = 0; j < 4; ++j) { const int n = (lane >> 3) + 8 * j; const LAS float* s = scr + (8 * c) * 33 + n;
        u32x4 o; o.x = cvt_pk_bf16(s[0 * 33], s[1 * 33]); o.y = cvt_pk_bf16(s[2 * 33], s[3 * 33]); o.z = cvt_pk_bf16(s[4 * 33], s[5 * 33]); o.w = cvt_pk_bf16(s[6 * 33], s[7 * 33]);
        *(u32x4*)(WT + (size_t)(n0 + n) * K + k0 + 8 * c) = o; }
    asm volatile("s_waitcnt lgkmcnt(0)" ::: "memory");
}
__device__ __forceinline__ void row_phase(const float* xp, const float* xs, const bf16_t* D, const float* PART, int nk, const float* gpost, float scale, float* X, const float* gpre, bf16_t* H, int gw, int ngw, int r0 = 0) {
    const int lane = fresh_tid() & 63;
    for (int rowa = r0 + gw; rowa < T; rowa += 2 * ngw) {
        const int rowb = rowa + ngw; const bool hasb = rowb < T;
        f32x4 v[2][4]; u32x2 dw[2][4];
#pragma unroll
        for (int k = 0; k < 2; ++k) { const int row = k ? rowb : rowa;
            if (k == 0 || hasb) {
                const float* xr = row < TP ? xp + (size_t)row * DM : xs + (size_t)(row - TP) * DM;
#pragma unroll
                for (int j = 0; j < 4; ++j) v[k][j] = *(const f32x4*)(xr + 4 * lane + 256 * j);
                if (D && row < TP) {
#pragma unroll
                    for (int j = 0; j < 4; ++j) dw[k][j] = *(const u32x2*)(D + (size_t)row * DM + 4 * lane + 256 * j);
                }
            } }
#pragma unroll
        for (int k = 0; k < 2; ++k) { const int row = k ? rowb : rowa;
            if (k == 0 || hasb) {
                if (D) {
                    f32x4 d[4]; float ss = 0.f;
#pragma unroll
                    for (int j = 0; j < 4; ++j) {
                        if (row < TP) { const u32x2 w = dw[k][j]; d[j] = (f32x4){bf_lo(w.x), bf_hi(w.x), bf_lo(w.y), bf_hi(w.y)}; }
                        else { d[j] = (f32x4){0.f, 0.f, 0.f, 0.f}; for (int kc = 0; kc < nk; ++kc) d[j] += *(const f32x4*)(PART + ((size_t)kc * TS + (row - TP)) * DM + 4 * lane + 256 * j); }
                        ss += (d[j][0] * d[j][0] + d[j][1] * d[j][1]) + (d[j][2] * d[j][2] + d[j][3] * d[j][3]); }
                    const float rs = scale * __builtin_amdgcn_rsqf(wave_sum(ss) * (1.0f / DM) + EPS);
#pragma unroll
                    for (int j = 0; j < 4; ++j) { const f32x4 g = *(const f32x4*)(gpost + 4 * lane + 256 * j); v[k][j] = v[k][j] + d[j] * g * rs; *(f32x4*)(X + (size_t)row * DM + 4 * lane + 256 * j) = v[k][j]; }
                }
                if (gpre) {
                    float ss = 0.f;
#pragma unroll
                    for (int j = 0; j < 4; ++j) ss += (v[k][j][0] * v[k][j][0] + v[k][j][1] * v[k][j][1]) + (v[k][j][2] * v[k][j][2] + v[k][j][3] * v[k][j][3]);
                    const float rs = __builtin_amdgcn_rsqf(wave_sum(ss) * (1.0f / DM) + EPS);
#pragma unroll
                    for (int j = 0; j < 4; ++j) { const f32x4 g = *(const f32x4*)(gpre + 4 * lane + 256 * j); const f32x4 h = v[k][j] * g * rs;
                        u32x2 w; w.x = cvt_pk_bf16(h[0], h[1]); w.y = cvt_pk_bf16(h[2], h[3]); *(u32x2*)(H + (size_t)row * DM + 4 * lane + 256 * j) = w; }
                }
            } }
    }
}

constexpr int KP = 272, VP = 320;
constexpr int KTB = 64 * KP, VTB = 64 * VP, TILEB = KTB + VTB;
__device__ __forceinline__ void attn_unit(lds_t* lds, const bf16_t* P, const bf16_t* KC, const bf16_t* VC, bf16_t* Y, const float* dg, float lam, int kind, int b, int h, int qb) {
    int tid = threadIdx.x; asm volatile("" : "+v"(tid));
    const int lane = tid & 63, wid = __builtin_amdgcn_readfirstlane(tid >> 6), ql = lane & 31, hi = lane >> 5, qg = wid >> 1, c = wid & 1;
    const int qrow0 = kind == 0 ? b * SEQ + qb * 128 : TP + b * DSEQ;
    const int NT = kind == 0 ? 2 * qb + 2 : 65;
    const bool active = kind == 0 ? true : (qg < 2);
    const int my_nt = kind == 0 ? 2 * qb + 1 + (qg >> 1) : (active ? 65 : 0);
    bf16x8 qf[4];
    {
        const bf16_t* qp = P + (size_t)(qrow0 + (active ? 32 * qg + ql : 0)) * NIN + 2048 + h * 128 + c * 64 + 8 * hi;
#pragma unroll
        for (int ks = 0; ks < 4; ++ks) qf[ks] = *(const bf16x8*)(qp + 16 * ks);
    }
    f32x16 o[4];
#pragma unroll
    for (int e = 0; e < 4; ++e)
#pragma unroll
        for (int r = 0; r < 16; ++r) o[e][r] = 0.f;
    float mref = 0.f, lsum = 0.f; f32x16 negm;
#pragma unroll
    for (int r = 0; r < 16; ++r) negm[r] = 0.f;
    asm volatile("" : "+v"(negm));
    const int srow0 = tid >> 4, sch = tid & 15;
    u32x4 kA[2], vA[2], kB[2], vB[2];
    auto load_tile = [&](int t, u32x4 (&kreg)[2], u32x4 (&vreg)[2]) {
        const bf16_t *kb, *vb; size_t pitch;
        if (kind == 0) { kb = P + (size_t)(b * SEQ + t * 64) * NIN + 2560 + h * 128; vb = kb + 512; pitch = NIN; }
        else if (t < 64) { kb = KC + (size_t)(b * PAST + t * 64) * 512 + h * 128; vb = VC + (size_t)(b * PAST + t * 64) * 512 + h * 128; pitch = 512; }
        else { kb = P + (size_t)(TP + b * DSEQ) * NIN + 2560 + h * 128; vb = kb + 512; pitch = NIN; }
#pragma unroll
        for (int i = 0; i < 2; ++i) { const int row = srow0 + 32 * i; kreg[i] = *(const u32x4*)(kb + row * pitch + sch * 8); vreg[i] = *(const u32x4*)(vb + row * pitch + sch * 8); }
    };
    auto store_tile = [&](int buf, const u32x4 (&kreg)[2], const u32x4 (&vreg)[2]) {
        lds_t* kl = lds + buf * TILEB; lds_t* vl = kl + KTB;
#pragma unroll
        for (int i = 0; i < 2; ++i) { const int row = srow0 + 32 * i; *(LAS u32x4*)(kl + row * KP + sch * 16) = kreg[i]; *(LAS u32x4*)(vl + row * VP + sch * 16) = vreg[i]; }
    };
    const int troff = tr_lane_off(lane, 4, VP);
    auto compute_tile = [&](int buf, bool first) {
        const lds_t* kl = lds + buf * TILEB; const lds_t* vl = kl + KTB;
        f32x16 s0, s1;
#pragma unroll
        for (int ks = 0; ks < 4; ++ks) {
            const bf16x8 a0 = *(const LAS bf16x8*)(kl + ql * KP + (c * 64 + 16 * ks + 8 * hi) * 2);
            const bf16x8 a1 = *(const LAS bf16x8*)(kl + (32 + ql) * KP + (c * 64 + 16 * ks + 8 * hi) * 2);
            if (ks == 0) { s0 = MFMA32(a0, qf[0], negm); s1 = MFMA32(a1, qf[0], negm); }
            else { s0 = MFMA32(a0, qf[ks], s0); s1 = MFMA32(a1, qf[ks], s1); }
        }
        asm volatile("s_nop 15\n\ts_nop 7" : "+v"(s0), "+v"(s1));
        float ma = max3f(s0[0], s0[1], s1[0]), mb = max3f(s0[2], s0[3], s1[1]); ma = max3f(ma, s1[2], s1[3]);
#pragma unroll
        for (int r = 4; r < 16; r += 4) { ma = max3f(ma, s0[r], s0[r + 1]); mb = max3f(mb, s0[r + 2], s0[r + 3]); ma = max3f(ma, s1[r], s1[r + 1]); mb = max3f(mb, s1[r + 2], s1[r + 3]); }
        const float rm = half_swap_max(fmaxf(ma, mb));
        if (first || __any(rm > 8.0f)) {
            const float dl = first ? rm : fmaxf(rm, 0.f);
            mref += dl;
#pragma unroll
            for (int r = 0; r < 16; ++r) { s0[r] -= dl; s1[r] -= dl; negm[r] = -mref; }
            asm volatile("" : "+v"(negm));
            if (!first) { const float f = __builtin_amdgcn_exp2f(-dl); lsum *= f;
#pragma unroll
                for (int e = 0; e < 4; ++e)
#pragma unroll
                    for (int r = 0; r < 16; ++r) o[e][r] *= f; }
        }
        float ps = 0.f;
#pragma unroll
        for (int r = 0; r < 16; ++r) { s0[r] = __builtin_amdgcn_exp2f(s0[r]); s1[r] = __builtin_amdgcn_exp2f(s1[r]); ps += s0[r] + s1[r]; }
        lsum += ps;
        bf16x8 pf[4];
        pf[0] = pack8(s0[0], s0[1], s0[2], s0[3], s0[4], s0[5], s0[6], s0[7]);
        pf[1] = pack8(s0[8], s0[9], s0[10], s0[11], s0[12], s0[13], s0[14], s0[15]);
        pf[2] = pack8(s1[0], s1[1], s1[2], s1[3], s1[4], s1[5], s1[6], s1[7]);
        pf[3] = pack8(s1[8], s1[9], s1[10], s1[11], s1[12], s1[13], s1[14], s1[15]);
#pragma unroll
        for (int ks = 0; ks < 4; ++ks) {
#pragma unroll
            for (int e = 0; e < 4; ++e) { const bf16x8 a = tr_frag<8>(vl + troff + (16 * ks) * VP + (32 * e) * 2, VP); o[e] = MFMA32(a, pf[ks], o[e]); }
            __builtin_amdgcn_sched_barrier(0);
        }
    };
    load_tile(0, kA, vA); store_tile(0, kA, vA);
    if (NT > 1) load_tile(1, kB, vB);
    __syncthreads();
    for (int t = 0; t < NT; t += 2) {
        if (t + 2 < NT) load_tile(t + 2, kA, vA);
        if (t < my_nt) compute_tile(0, t == 0);
        if (t + 1 < NT) store_tile(1, kB, vB);
        __syncthreads();
        if (t + 1 >= NT) break;
        if (t + 3 < NT) load_tile(t + 3, kB, vB);
        if (t + 1 < my_nt) compute_tile(1, false);
        if (t + 2 < NT) store_tile(0, kA, vA);
        __syncthreads();
    }
    const float lt = half_swap_sum(lsum);
    const float inv = active ? 1.0f / lt : 0.f;
    LAS float* comb = (LAS float*)lds;
    lds_t* stg = lds + 65536;
    if (active && c == 1) {
        const float f = lam * inv;
#pragma unroll
        for (int e = 0; e < 4; ++e)
#pragma unroll
            for (int r = 0; r < 16; ++r) comb[(qg * 128 + 32 * e + crow(r, hi)) * 32 + ql] = o[e][r] * f;
    }
    __syncthreads();
    if (active && c == 0) {
        float ss = 0.f;
#pragma unroll
        for (int e = 0; e < 4; ++e)
#pragma unroll
            for (int r = 0; r < 16; ++r) { const float v = o[e][r] * inv - comb[(qg * 128 + 32 * e + crow(r, hi)) * 32 + ql]; o[e][r] = v; ss += v * v; }
        ss = half_swap_sum(ss);
        const float rs = __builtin_amdgcn_rsqf(ss * (1.0f / 128.0f) + EPS) * (1.0f - LAM_INIT);
#pragma unroll
        for (int e = 0; e < 4; ++e)
#pragma unroll
            for (int r = 0; r < 16; ++r) { const int ee = 32 * e + crow(r, hi); *(LAS bf16_t*)(stg + (qg * 32 + ql) * KP + ee * 2) = f2bf(o[e][r] * rs); }
    }
    __syncthreads();
    {
        const int nrows = kind == 0 ? 128 : 64;
        const f32x4 g0 = *(const f32x4*)(dg + (tid & 15) * 8), g1 = *(const f32x4*)(dg + (tid & 15) * 8 + 4);
        for (int cid = tid; cid < nrows * 16; cid += 512) { const int row = cid >> 4, ch = cid & 15;
            const u32x4 v = *(const LAS u32x4*)(stg + row * KP + ch * 16);
            u32x4 w; w.x = cvt_pk_bf16(bf_lo(v.x) * g0[0], bf_hi(v.x) * g0[1]); w.y = cvt_pk_bf16(bf_lo(v.y) * g0[2], bf_hi(v.y) * g0[3]);
            w.z = cvt_pk_bf16(bf_lo(v.z) * g1[0], bf_hi(v.z) * g1[1]); w.w = cvt_pk_bf16(bf_lo(v.w) * g1[2], bf_hi(v.w) * g1[3]);
            *(u32x4*)(Y + (size_t)(qrow0 + row) * DM + 512 + h * 128 + ch * 8) = w; }
    }
    __syncthreads();
}

__device__ __forceinline__ void ret_unit_rows(int sbi, int& row0, int& h) {
    if (sbi < 2048) { const int n = sbi & 63, bh = sbi >> 6; h = bh & 3; row0 = (bh >> 2) * SEQ + n * 64; }
    else { const int bh = sbi - 2048; h = bh & 3; row0 = TP + (bh >> 2) * DSEQ; }
}
__device__ __forceinline__ float ret_lg2(int h) { return __log2f(1.0f - exp2f(-5.0f - (float)h)); }
__device__ __forceinline__ void ret_seq_unit(lds_t* lds, const bf16_t* P, bf16_t* SB, float* out_ret, const float* state_in, int bh, bool is_sample) {
    const int tid = fresh_tid();
    const int lane = tid & 63, wid = __builtin_amdgcn_readfirstlane(tid >> 6), hi = lane >> 5, l31 = lane & 31;
    const int h = bh & 3, b = bh >> 2;
    const int nch = is_sample ? 1 : 64;
    const int rowbase = is_sample ? TP + b * DSEQ : b * SEQ;
    const int sb0 = is_sample ? 2048 + bh : bh * 64;
    const float lg = ret_lg2(h), dec64 = exp2f(lg * 64.0f);
    const int troff = tr_lane_off(lane, 8, VP);
    const int dt = wid >> 1, e0 = (wid & 1) * 2;
    const int srow = tid >> 4, sch = tid & 15;
    u32x4 kA[2], vA[2], kB[2], vB[2];
    auto load = [&](int n, u32x4 (&kr)[2], u32x4 (&vr)[2]) {
#pragma unroll
        for (int i = 0; i < 2; ++i) { const bf16_t* src = P + (size_t)(rowbase + n * 64 + srow + 32 * i) * NIN + h * 128 + sch * 8; kr[i] = *(const u32x4*)(src + 512); vr[i] = *(const u32x4*)(src + 1024); } };
    const float dec0 = exp2f(lg * (float)(63 - srow)), dec1 = exp2f(lg * (float)(31 - srow));
    auto stage = [&](int buf, const u32x4 (&kr)[2], const u32x4 (&vr)[2]) {
        lds_t* kl = lds + buf * (2 * VTB); lds_t* vl = kl + VTB;
#pragma unroll
        for (int i = 0; i < 2; ++i) { const int row = srow + 32 * i; const u32x4 kv = kr[i];
            const float dec = i ? dec1 : dec0;
            u32x4 ks; ks.x = cvt_pk_bf16(bf_lo(kv.x) * dec, bf_hi(kv.x) * dec); ks.y = cvt_pk_bf16(bf_lo(kv.y) * dec, bf_hi(kv.y) * dec);
            ks.z = cvt_pk_bf16(bf_lo(kv.z) * dec, bf_hi(kv.z) * dec); ks.w = cvt_pk_bf16(bf_lo(kv.w) * dec, bf_hi(kv.w) * dec);
            *(LAS u32x4*)(kl + row * VP + sch * 16) = ks; *(LAS u32x4*)(vl + row * VP + sch * 16) = vr[i]; } };
    f32x16 acc[2];
#pragma unroll
    for (int e = 0; e < 2; ++e)
#pragma unroll
        for (int r = 0; r < 16; ++r) acc[e][r] = is_sample ? state_in[((size_t)bh * 128 + 32 * dt + crow(r, hi)) * 128 + 32 * (e0 + e) + l31] : 0.f;
    auto step = [&](int n, int buf) {
        const lds_t* kl = lds + buf * (2 * VTB); const lds_t* vl = kl + VTB;
        bf16_t* ob = SB + (size_t)(sb0 + n) * 16384;
#pragma unroll
        for (int e = 0; e < 2; ++e)
#pragma unroll
            for (int r = 0; r < 16; ++r) { ob[(32 * dt + crow(r, hi)) * 128 + 32 * (e0 + e) + l31] = f2bf(acc[e][r]); acc[e][r] *= dec64; }
#pragma unroll
        for (int ks = 0; ks < 4; ++ks) {
            const bf16x8 a = tr_frag<4>(kl + troff + (16 * ks) * VP + (32 * dt) * 2, VP);
#pragma unroll
            for (int e = 0; e < 2; ++e) { const bf16x8 bb = tr_frag<4>(vl + troff + (16 * ks) * VP + (32 * (e0 + e)) * 2, VP); acc[e] = MFMA32(a, bb, acc[e]); }
        }
    };
    load(0, kA, vA);
    if (nch > 1) load(1, kB, vB);
    for (int n = 0; n < nch; n += 2) {
        stage(0, kA, vA); __syncthreads();
        if (n + 2 < nch) load(n + 2, kA, vA);
        step(n, 0);
        if (n + 1 >= nch) break;
        stage(1, kB, vB); __syncthreads();
        if (n + 3 < nch) load(n + 3, kB, vB);
        step(n + 1, 1);
    }
    __syncthreads();
#pragma unroll
    for (int e = 0; e < 2; ++e)
#pragma unroll
        for (int r = 0; r < 16; ++r) out_ret[((size_t)bh * 128 + 32 * dt + crow(r, hi)) * 128 + 32 * (e0 + e) + l31] = acc[e][r];
}
__device__ __forceinline__ void ret_out_units(lds_t* lds, const bf16_t* P, const bf16_t* SB, bf16_t* Y, const float* rg, int first, int stride, int nunits) {
    int tid = threadIdx.x; asm volatile("" : "+v"(tid));
    const int lane = tid & 63, wid = __builtin_amdgcn_readfirstlane(tid >> 6), hi = lane >> 5, l31 = lane & 31;
    lds_t* ql = lds; lds_t* kl = lds + KTB; lds_t* vl = lds + 2 * KTB; lds_t* sl = lds + 2 * KTB + VTB;
    LAS float* red = (LAS float*)(lds + 2 * KTB + VTB + 128 * VP);
    u32x4 rq[2], rk[2], rv[2], rs[4];
    auto load_regs = [&](int sb) { int r0_, h_; ret_unit_rows(sb, r0_, h_);
#pragma unroll
        for (int i = 0; i < 2; ++i) { const int cid = tid + 512 * i, row = cid >> 4, ch = cid & 15;
            const bf16_t* src = P + (size_t)(r0_ + row) * NIN + h_ * 128 + ch * 8;
            rq[i] = *(const u32x4*)(src); rk[i] = *(const u32x4*)(src + 512); rv[i] = *(const u32x4*)(src + 1024); }
#pragma unroll
        for (int i = 0; i < 4; ++i) { const int cid = tid + 512 * i, row = cid >> 4, ch = cid & 15;
            rs[i] = *(const u32x4*)(SB + (size_t)sb * 16384 + row * 128 + ch * 8); } };
    if (first < nunits) load_regs(first);
  for (int sbi = first; sbi < nunits; sbi += stride) {
    int row0, h; ret_unit_rows(sbi, row0, h);
    const float lg = ret_lg2(h);
#pragma unroll
    for (int i = 0; i < 2; ++i) { const int cid = tid + 512 * i, row = cid >> 4, ch = cid & 15;
        *(LAS u32x4*)(ql + row * KP + ch * 16) = rq[i];
        *(LAS u32x4*)(kl + row * KP + ch * 16) = rk[i];
        *(LAS u32x4*)(vl + row * VP + ch * 16) = rv[i]; }
#pragma unroll
    for (int i = 0; i < 4; ++i) { const int cid = tid + 512 * i, row = cid >> 4, ch = cid & 15;
        *(LAS u32x4*)(sl + row * VP + ch * 16) = rs[i]; }
    __syncthreads();
    if (sbi + stride < nunits) load_regs(sbi + stride);
    const int et = wid & 3, it = wid >> 2;
    const int i_row = 32 * it + l31;
    bf16x8 qf[8];
#pragma unroll
    for (int ks = 0; ks < 8; ++ks) qf[ks] = *(const LAS bf16x8*)(ql + i_row * KP + (16 * ks + 8 * hi) * 2);
    f32x16 acc;
#pragma unroll
    for (int r = 0; r < 16; ++r) acc[r] = 0.f;
    const int troff8 = tr_lane_off(lane, 8, VP), troff4 = tr_lane_off(lane, 4, VP);
#pragma unroll
    for (int ks = 0; ks < 8; ++ks) { const bf16x8 a = tr_frag<4>(sl + troff8 + (16 * ks) * VP + (32 * et) * 2, VP); acc = MFMA32(a, qf[ks], acc); }
    { const float qd = exp2f(lg * (float)(i_row + 1));
#pragma unroll
      for (int r = 0; r < 16; ++r) acc[r] *= qd; }
#pragma unroll
    for (int jt = 0; jt < 2; ++jt) {
        if (jt <= it) {
            f32x16 s;
#pragma unroll
            for (int r = 0; r < 16; ++r) s[r] = 0.f;
#pragma unroll
            for (int ks = 0; ks < 8; ++ks) { const bf16x8 a = *(const LAS bf16x8*)(kl + (32 * jt + l31) * KP + (16 * ks + 8 * hi) * 2); s = MFMA32(a, qf[ks], s); }
#pragma unroll
            for (int r = 0; r < 16; ++r) { const int j = 32 * jt + crow(r, hi); const int d = i_row - j; s[r] = d >= 0 ? s[r] * exp2f(lg * (float)d) : 0.f; }
            const bf16x8 p0 = pack8(s[0], s[1], s[2], s[3], s[4], s[5], s[6], s[7]);
            const bf16x8 p1 = pack8(s[8], s[9], s[10], s[11], s[12], s[13], s[14], s[15]);
            { const bf16x8 a = tr_frag<8>(vl + troff4 + (32 * jt) * VP + (32 * et) * 2, VP); acc = MFMA32(a, p0, acc); }
            { const bf16x8 a = tr_frag<8>(vl + troff4 + (32 * jt + 16) * VP + (32 * et) * 2, VP); acc = MFMA32(a, p1, acc); }
        }
    }
    float s1 = 0.f, s2 = 0.f;
#pragma unroll
    for (int r = 0; r < 16; ++r) { s1 += acc[r]; s2 += acc[r] * acc[r]; }
    s1 = half_swap_sum(s1); s2 = half_swap_sum(s2);
    if (hi == 0) { red[((it * 4 + et) * 32 + l31) * 2] = s1; red[((it * 4 + et) * 32 + l31) * 2 + 1] = s2; }
    __syncthreads();
    float t1 = 0.f, t2 = 0.f;
#pragma unroll
    for (int e = 0; e < 4; ++e) { t1 += red[((it * 4 + e) * 32 + l31) * 2]; t2 += red[((it * 4 + e) * 32 + l31) * 2 + 1]; }
    const float mu = t1 * (1.0f / 128.0f), var = fmaxf(t2 * (1.0f / 128.0f) - mu * mu, 0.f), rs = __builtin_amdgcn_rsqf(var + EPS);
    lds_t* stg = lds;
#pragma unroll
    for (int r = 0; r < 16; ++r) { const int e = 32 * et + crow(r, hi); *(LAS bf16_t*)(stg + i_row * KP + e * 2) = f2bf((acc[r] - mu) * rs); }
    __syncthreads();
    {
        const int ch = tid & 15;
        const f32x4 g0 = *(const f32x4*)(rg + h * 128 + ch * 8), g1 = *(const f32x4*)(rg + h * 128 + ch * 8 + 4);
        u32x4 gtv[2];
#pragma unroll
        for (int i = 0; i < 2; ++i) gtv[i] = *(const u32x4*)(P + (size_t)(row0 + (tid >> 4) + 32 * i) * NIN + 1536 + h * 128 + ch * 8);
#pragma unroll
        for (int i = 0; i < 2; ++i) { const int row = (tid >> 4) + 32 * i;
            const u32x4 v = *(const LAS u32x4*)(stg + row * KP + ch * 16);
            const u32x4 gt = gtv[i];
            u32x4 w;
            w.x = cvt_pk_bf16(bf_lo(v.x) * g0[0] * fast_silu(bf_lo(gt.x)), bf_hi(v.x) * g0[1] * fast_silu(bf_hi(gt.x)));
            w.y = cvt_pk_bf16(bf_lo(v.y) * g0[2] * fast_silu(bf_lo(gt.y)), bf_hi(v.y) * g0[3] * fast_silu(bf_hi(gt.y)));
            w.z = cvt_pk_bf16(bf_lo(v.z) * g1[0] * fast_silu(bf_lo(gt.z)), bf_hi(v.z) * g1[1] * fast_silu(bf_hi(gt.z)));
            w.w = cvt_pk_bf16(bf_lo(v.w) * g1[2] * fast_silu(bf_lo(gt.w)), bf_hi(v.w) * g1[3] * fast_silu(bf_hi(gt.w)));
            *(u32x4*)(Y + (size_t)(row0 + row) * DM + h * 128 + ch * 8) = w; }
    }
    __syncthreads();
  }
}

#define XB_TMO      128
#define XB_XCNT(j)  (256  + 64 * (j))
#define XB_XSUB(j)  (1280 + 64 * (j))
#define XB_XGEN(j)  (2304 + 64 * (j))
#define XB_TOP      3328
#define XB_TOPGEN   3392
#define XCD_BAR_WORDS 3456
#define XB_SPIN_CAP (1u << 20)
constexpr int CW_BAR = 49152;
__device__ __forceinline__ unsigned xb_ld(unsigned* p)              { return __hip_atomic_load(p, __ATOMIC_RELAXED, __HIP_MEMORY_SCOPE_AGENT); }
__device__ __forceinline__ unsigned xb_add(unsigned* p, unsigned v) { return __hip_atomic_fetch_add(p, v, __ATOMIC_RELAXED, __HIP_MEMORY_SCOPE_AGENT); }
__device__ __forceinline__ unsigned xb_xcc_id() { return (unsigned)__builtin_amdgcn_s_getreg((3 << 11) | 20) & 0xFu; }
#define XB_SPIN(cond, bar) do { unsigned _sp = 0; while (cond) { __builtin_amdgcn_s_sleep(1); \
    if ((++_sp & 255u) == 0u) { if (xb_ld(&(bar)[XB_TMO])) break; if (_sp > XB_SPIN_CAP) { atomicAdd(&(bar)[XB_TMO], 1u); break; } } } } while (0)
struct XcdBarrier { unsigned* bar; unsigned x; volatile LAS unsigned* st; };
__device__ __forceinline__ XcdBarrier xcd_barrier_post(unsigned* bar, volatile LAS unsigned* st) {
    XcdBarrier b; b.bar = bar; b.x = xb_xcc_id(); b.st = st;
    if (threadIdx.x == 0) (void)xb_add(&bar[XB_XCNT(b.x)], 1u);
    return b;
}
__device__ __forceinline__ void xcd_barrier_complete(unsigned* bar, unsigned x, unsigned& nloc, unsigned& nx) {
    const unsigned G = gridDim.x * gridDim.y * gridDim.z;
    unsigned sum, cnt, mine, sp = 0u;
    for (;;) {
        sum = 0u; cnt = 0u; mine = 0u;
#pragma unroll
        for (unsigned j = 0; j < 16; ++j) { const unsigned c = xb_ld(&bar[XB_XCNT(j)]); sum += c; cnt += (c > 0u) ? 1u : 0u; mine = (j == x) ? c : mine; }
        if (sum == G) break;
        __builtin_amdgcn_s_sleep(1);
        if ((++sp & 255u) == 0u) { if (xb_ld(&bar[XB_TMO])) break; if (sp > XB_SPIN_CAP) { atomicAdd(&bar[XB_TMO], 1u); break; } }
    }
    nloc = mine > 0u ? mine : 1u; nx = cnt > 0u ? cnt : 1u;
}
__device__ __forceinline__ void xcd_barrier(const XcdBarrier& b) {
    asm volatile("s_waitcnt vmcnt(0)" ::: "memory");
    __syncthreads();
    if (threadIdx.x == 0) {
        unsigned* bar = b.bar;
        __builtin_amdgcn_s_waitcnt(0);
        unsigned nloc = b.st[0], nx = b.st[1];
        if (nloc == 0u) { xcd_barrier_complete(bar, b.x, nloc, nx); b.st[0] = nloc; b.st[1] = nx; }
        const unsigned old = xb_add(&bar[XB_XSUB(b.x)], 1u);
        const unsigned gen = old / nloc;
        if (old + 1u == (gen + 1u) * nloc) {
            __builtin_amdgcn_fence(__ATOMIC_RELEASE, "agent");
            asm volatile("s_waitcnt vmcnt(0)" ::: "memory");
            const unsigned og = xb_add(&bar[XB_TOP], 1u);
            const unsigned tg = og / nx;
            if (og + 1u == (tg + 1u) * nx) xb_add(&bar[XB_TOPGEN], 1u);
            else XB_SPIN(xb_ld(&bar[XB_TOPGEN]) == tg, bar);
            __builtin_amdgcn_fence(__ATOMIC_ACQUIRE, "agent");
            xb_add(&bar[XB_XGEN(b.x)], 1u);
            asm volatile("s_waitcnt vmcnt(0)" ::: "memory");
        } else {
            XB_SPIN(xb_ld(&bar[XB_XGEN(b.x)]) == gen, bar);
            __builtin_amdgcn_fence(__ATOMIC_ACQUIRE, "agent");
            asm volatile("s_waitcnt vmcnt(0)" ::: "memory");
        }
    }
    __syncthreads();
}
__device__ __forceinline__ bool grid_sync_fn(cg::grid_group& grid) { asm volatile("s_waitcnt vmcnt(0) lgkmcnt(0)" ::: "memory"); __builtin_amdgcn_fence(__ATOMIC_RELEASE, "workgroup"); grid.sync(); return true; }
__global__ void __launch_bounds__(512, 2) fwd_kernel(Params p) {
    extern __shared__ __attribute__((aligned(16))) unsigned char lds_raw[];
    lds_t* lds = (lds_t*)lds_raw;
    cg::grid_group grid = cg::this_grid();
    const int G = gridDim.x, bx = blockIdx.x;
    const int wave = __builtin_amdgcn_readfirstlane((int)threadIdx.x >> 6);
    const int gw = bx * 8 + wave, ngw = G * 8;
    if (threadIdx.x < 4) ((LAS unsigned*)(lds + LDS_MISC + 16))[threadIdx.x] = 0u;
    __syncthreads();
    unsigned* ctlw = (unsigned*)(p.ws + WS_CTL);
    if (bx == 0) {
        const int t_ = threadIdx.x;
        for (int i = t_; i < XCD_BAR_WORDS; i += 512) __hip_atomic_store(ctlw + CW_BAR + i, 0u, __ATOMIC_RELAXED, __HIP_MEMORY_SCOPE_AGENT);
        for (int i = t_; i < 5 * 128; i += 512) __hip_atomic_store(ctlw + CW_CNT + (i >> 7) * CW_CNT_EX + (i & 127) * 64, 0u, __ATOMIC_RELAXED, __HIP_MEMORY_SCOPE_AGENT);
        if (t_ < 2) __hip_atomic_store(ctlw + t_, 0u, __ATOMIC_RELAXED, __HIP_MEMORY_SCOPE_AGENT);
    }
    GRID_SYNC();
    const XcdBarrier xbar = xcd_barrier_post(ctlw + CW_BAR, (volatile LAS unsigned*)(lds + LDS_MISC + 16));
#define ctl ((unsigned*)(p.ws + WS_CTL))
#define RT ((float*)(p.ws + WS_RT))
#define DT ((float*)(p.ws + WS_DT))
#define WGU1 ((bf16_t*)(p.ws + WS_WGU1))
#define WD1 ((bf16_t*)(p.ws + WS_WD1))
#define WIN ((bf16_t*)(p.ws + WS_WIN))
#define WOUT ((bf16_t*)(p.ws + WS_WOUT))
#define WGU2 ((bf16_t*)(p.ws + WS_WGU2))
#define WD2 ((bf16_t*)(p.ws + WS_WD2))
#define H ((bf16_t*)(p.ws + WS_H))
#define D ((bf16_t*)(p.ws + WS_D))
#define SB ((bf16_t*)(p.ws + WS_D))
#define KC ((bf16_t*)(p.ws + WS_KC))
#define VC ((bf16_t*)(p.ws + WS_VC))
#define BIG ((bf16_t*)(p.ws + WS_BIG))
#define X (p.out + OY)
#define PART ((float*)(p.ws + WS_PART))
#define X1B ((bf16_t*)p.out)
#define X2B ((bf16_t*)(p.ws + WS_D))
#define SLOT(ex) ((float*)(p.ws + WS_SLOT) + (size_t)(ex) * 128 * 256 * 4)
#define CNT(ex) (ctl + CW_CNT + (ex) * CW_CNT_EX)
    constexpr int I_GU = 16 * 176, I_D = 44 * 32, I_IN = 16 * 112, I_OUT = 16 * 32, NITEMS = 2 * I_GU + 2 * I_D + I_IN + I_OUT;
    auto convert_items = [&](int lo, int hi, int w0, int nw) {
        const int lane = fresh_tid() & 63;
        LAS float* scr = (LAS float*)(lds + wave * 16384);
        for (int it = lo + w0; it < hi; it += nw) {
            int r = it;
            if (r < 2 * I_GU) { const int f = r >= I_GU; r -= f * I_GU; const int kb = r / 176, nb = r % 176, isup = (nb >> 2) & 1;
                const float* W = p.in[f ? (isup ? 22 : 21) : (isup ? 7 : 6)];
                transpose_item(W, DM, DFF, f ? WGU2 : WGU1, scr, 64 * kb, 32 * nb, lane, [](int nd) { return (nd >> 8) * 128 + (nd & 127); }); continue; }
            r -= 2 * I_GU;
            if (r < 2 * I_D) { const int f = r >= I_D; r -= f * I_D; transpose_item(p.in[f ? 23 : 8], DFF, DM, f ? WD2 : WD1, scr, 64 * (r / 32), 32 * (r % 32), lane, [](int n) { return n; }); continue; }
            r -= 2 * I_D;
            if (r < I_IN) { transpose_item(p.in[11], DM, NIN, WIN, scr, 64 * (r / 112), 32 * (r % 112), lane, [](int n) { return win_srccol(n); }); continue; }
            r -= I_IN;
            transpose_item(p.in[18], DM, DM, WOUT, scr, 64 * (r / 32), 32 * (r % 32), lane, [](int n) { return n; });
        }
    };
    auto convert_cache = [&](size_t t0, size_t nt) {
        const size_t n8 = (size_t)8 * PAST * 512 / 8;
#pragma unroll 1
        for (int isv = 0; isv < 2; ++isv) {
            const f32x4* s = (const f32x4*)(p.in[isv ? 4 : 3]); u32x4* d = (u32x4*)(isv ? VC : KC);
#pragma unroll 1
            for (size_t i = t0; i < n8; i += 4 * nt) {
                f32x4 a[4], c[4];
#pragma unroll
                for (int u = 0; u < 4; ++u) { const size_t j = i + u * nt; if (j < n8) { a[u] = s[2 * j]; c[u] = s[2 * j + 1]; } }
#pragma unroll
                for (int u = 0; u < 4; ++u) { const size_t j = i + u * nt; if (j < n8) {
                    u32x4 w; w.x = cvt_pk_bf16(a[u][0], a[u][1]); w.y = cvt_pk_bf16(a[u][2], a[u][3]); w.z = cvt_pk_bf16(c[u][0], c[u][1]); w.w = cvt_pk_bf16(c[u][2], c[u][3]);
                    d[j] = w; } }
            }
        }
    };
    PH(0) {
        const int tid = fresh_tid(), lane = tid & 63;
        convert_items(0, I_GU, gw, ngw);
        row_phase(p.in[0], p.in[1], nullptr, nullptr, 0, nullptr, 0.f, nullptr, p.in[5], H, gw, ngw);
        { const int gt = bx * 512 + tid, ngt = G * 512;
          for (int i = gt; i < NPOS * 64; i += ngt) { const int pos = i >> 6, k = i & 63; const float inv = powf(10000.0f, -(float)k * (2.0f / 128.0f)); const float ang = (float)pos * inv;
              RT[2 * i] = cosf(ang); RT[2 * i + 1] = sinf(ang); }
          for (int i = gt; i < NPOS * 8; i += ngt) { const int pos = i >> 3, k = i & 7; const float inv = powf(500000.0f, -(float)k * (2.0f / 16.0f)); const float ang = (float)pos * inv;
              DT[2 * i] = cosf(ang); DT[2 * i + 1] = sinf(ang); } }
        if (bx == 0 && wave == 0) {
            const float a = wave_sum(p.in[13][lane] * p.in[14][lane]), b2 = wave_sum(p.in[15][lane] * p.in[16][lane]);
            if (lane == 0) ((float*)ctl)[64] = expf(a) - expf(b2) + LAM_INIT;
        }
    }
    XSYNC();
    PH(1) { pg8::Gemm g{H, WGU1, T, 2 * DFF, DM, DM}; pg8::StaticOrder S; S.init(T, 2 * DFF, G, bx); EpiSwiglu E{BIG}; pg8::gemm_phase(lds, g, S, E);
      { const int rem = ((T / 256) * (2 * DFF / 256)) % G;
        if (bx >= rem) convert_items(I_GU, NITEMS, (bx - rem) * 8 + wave, (G - rem) * 8); } }
    XSYNC();
    PH(2) { { pg8::Gemm g{BIG, WD1, TP, DM, DFF, DFF}; pg8::Order4 S; S.init(TP, G, bx); EpiResNorm<false, true> E{p.in[0], X1B, H, p.in[9], p.in[10], 0.5f, RowStat{SLOT(0), CNT(0)}, RowStat{SLOT(1), CNT(1)}, lds}; pg8::gemm_phase(lds, g, S, E); }
      { pg8::Gemm g{BIG + (size_t)TP * DFF, WD1, TS, DM, DFF, 256}; pg8::SplitOrder S; S.init(TS, DM, 11, G, bx); EpiPart E{PART}; pg8::gemm_phase(lds, g, S, E); } }
    XSYNC();
    PH(3) row_phase(p.in[0], p.in[1], D, PART, 11, p.in[9], 0.5f, X, p.in[10], H, gw, ngw, TP);
    XSYNC();
    PH(4) { pg8::Gemm g{H, WIN, T, NIN, DM, DM}; pg8::StaticOrder S; S.init(T, NIN, G, bx); EpiIn E{BIG, p.out, RT, DT}; pg8::gemm_phase(lds, g, S, E);
      { const int rem = ((T / 256) * (NIN / 256)) % G;
        if (bx >= rem) convert_cache((size_t)(bx - rem) * 512 + fresh_tid(), (size_t)(G - rem) * 512); } }
    XSYNC();
    PH(5) {
        const float lam = ((const float*)ctl)[64];
        const int tid = fresh_tid();
        LAS int* misc = (LAS int*)(lds + LDS_MISC);
        constexpr int NR_P = 32, NA_S = 32, NA_P = 1024, NR_S = 32;
        for (;;) {
            if (tid == 0) misc[0] = (int)atomicAdd(&ctl[rep_], 1u);
            __syncthreads();
            const int item = misc[0];
            __syncthreads();
            if (item >= NR_P + NA_S + NA_P + NR_S) break;
            if (item < NR_P) ret_seq_unit(lds, BIG, SB, p.out + ORET_P, nullptr, item, false);
            else if (item < NR_P + NA_S + NA_P) {
                const int ui = __builtin_amdgcn_readfirstlane(item) - NR_P; const int kind = ui < NA_S ? 1 : 0; const int r = ui - NA_S;
                const int qb = kind ? 0 : 31 - (r >> 5), bh = kind ? ui : (r & 31);
                attn_unit(lds, BIG, KC, VC, H, p.in[17], lam, kind, bh >> 2, bh & 3, qb); }
            else ret_seq_unit(lds, BIG, SB, p.out + ORET_S, p.in[2], item - NR_P - NA_S - NA_P, true);
        }
    }
    XSYNC();
    PH(7) ret_out_units(lds, BIG, SB, H, p.in[12], bx, G, 2080);
    XSYNC();
    PH(8) { { pg8::Gemm g{H, WOUT, TP, DM, DM, DM}; pg8::Order4 S; S.init(TP, G, bx); EpiResNorm<true, true> E{X1B, X2B, H, p.in[19], p.in[20], 1.0f, RowStat{SLOT(2), CNT(2)}, RowStat{SLOT(3), CNT(3)}, lds}; pg8::gemm_phase(lds, g, S, E); }
      { pg8::Gemm g{H + (size_t)TP * DM, WOUT, TS, DM, DM, 256}; pg8::SplitOrder S; S.init(TS, DM, 4, G, bx); EpiPart E{PART}; pg8::gemm_phase(lds, g, S, E); } }
    XSYNC();
    PH(9) row_phase(X, X + (size_t)TP * DM, D, PART, 4, p.in[19], 1.0f, X, p.in[20], H, gw, ngw, TP);
    XSYNC();
    PH(10) { pg8::Gemm g{H, WGU2, T, 2 * DFF, DM, DM}; pg8::StaticOrder S; S.init(T, 2 * DFF, G, bx); EpiSwiglu E{BIG}; pg8::gemm_phase(lds, g, S, E); }
    XSYNC();
    PH(11) { { pg8::Gemm g{BIG, WD2, TP, DM, DFF, DFF}; pg8::Order4 S; S.init(TP, G, bx); EpiResNorm<true, false> E{X2B, X, nullptr, p.in[24], nullptr, 0.5f, RowStat{SLOT(4), CNT(4)}, RowStat{SLOT(4), CNT(4)}, lds}; pg8::gemm_phase(lds, g, S, E); }
      { pg8::Gemm g{BIG + (size_t)TP * DFF, WD2, TS, DM, DFF, 256}; pg8::SplitOrder S; S.init(TS, DM, 11, G, bx); EpiPart E{PART}; pg8::gemm_phase(lds, g, S, E); } }
    XSYNC();
    PH(12) row_phase(X, X + (size_t)TP * DM, D, PART, 11, p.in[24], 0.5f, X, nullptr, nullptr, gw, ngw, TP);
}

#undef ctl
#undef RT
#undef DT
#undef WGU1
#undef WD1
#undef WIN
#undef WOUT
#undef WGU2
#undef WD2
#undef H
#undef D
#undef SB
#undef KC
#undef VC
#undef BIG
#undef X
#undef PART
#undef X1B
#undef X2B
#undef SLOT
#undef CNT
extern "C" void kernel_launch(void* const* d_in, const int* in_sizes, int n_in, void* d_out, int out_size, void* d_ws, size_t ws_size, hipStream_t stream) {
    static int grid = 0;
    if (grid == 0) {
        int dev = 0, cus = 0, per_cu = 0;
        (void)hipGetDevice(&dev);
        (void)hipDeviceGetAttribute(&cus, hipDeviceAttributeMultiprocessorCount, dev);
        if (hipFuncSetAttribute((const void*)fwd_kernel, hipFuncAttributeMaxDynamicSharedMemorySize, LDS_BYTES) != hipSuccess) fprintf(stderr, "kernel_launch: hipFuncSetAttribute failed\n");
        (void)hipOccupancyMaxActiveBlocksPerMultiprocessor(&per_cu, (const void*)fwd_kernel, 512, LDS_BYTES);
        if (per_cu < 1) { fprintf(stderr, "kernel_launch: occupancy query returned %d\n", per_cu); per_cu = 1; }
        (void)hipGetLastError();
        grid = cus * per_cu;
    }
    Params p{};
    for (int i = 0; i < 25; ++i) p.in[i] = (const float*)d_in[i];
    p.out = (float*)d_out; p.ws = (unsigned char*)d_ws;
    void* args[] = {&p};
    hipError_t e = hipLaunchCooperativeKernel((const void*)fwd_kernel, dim3(grid), dim3(512), args, LDS_BYTES, stream);
    if (e != hipSuccess) fprintf(stderr, "cooperative launch failed: %s (grid %d)\n", hipGetErrorString(e), grid);
}
```

```cpp
#include <hip/hip_runtime.h>
#include <hip/hip_cooperative_groups.h>
#include <cstdio>
#include <cstdint>
namespace cg = cooperative_groups;

#define LAS __attribute__((address_space(3)))
typedef unsigned short bf16_t;
typedef short bf16x8 __attribute__((ext_vector_type(8)));
typedef short s16x4 __attribute__((ext_vector_type(4)));
typedef float f32x4 __attribute__((ext_vector_type(4)));
typedef float f32x16 __attribute__((ext_vector_type(16)));
typedef unsigned u32x4 __attribute__((ext_vector_type(4)));
typedef unsigned u32x2 __attribute__((ext_vector_type(2)));
typedef LAS unsigned char lds_t;

constexpr int DM = 1024, TP = 32768, TS = 512, T = TP + TS, DFF = 2816, NIN = 3584;
constexpr int SEQ = 4096, PAST = 4096, DSEQ = 64;
constexpr float EPS = 1e-6f;
constexpr float QSCALE = 0.125f * 1.4426950408889634f;
constexpr float KRSCALE = 0.08838834764831845f;
constexpr float LAM_INIT = 0.2f;
constexpr size_t OY = 0, ORET_P = 34078720, OK_P = 34603008, OV_P = 51380224, ORET_S = 68157440, OK_S = 68681728, OV_S = 68943872;
constexpr size_t MiB = 1u << 20;
constexpr size_t WS_CTL = 0, WS_RT = 1 * MiB, WS_DT = 3 * MiB + 512 * 1024, WS_WGU1 = 4 * MiB, WS_WD1 = 15 * MiB, WS_WIN = 21 * MiB, WS_WOUT = 28 * MiB,
                 WS_WGU2 = 30 * MiB, WS_WD2 = 41 * MiB, WS_H = 47 * MiB, WS_D = 112 * MiB, WS_KC = 177 * MiB, WS_VC = 209 * MiB, WS_BIG = 241 * MiB, WS_PART = 470 * MiB, WS_SLOT = 496 * MiB;
constexpr int NPOS = 4160;
constexpr int LDS_BYTES = 147456;
constexpr int LDS_MISC = 131072;
constexpr int LDS_TAB = LDS_MISC + 256;
constexpr int CW_CNT = 1024, CW_CNT_EX = 8192;
#ifndef EPI_RT
#define EPI_RT 1
#endif
#ifndef EPI_DT
#define EPI_DT 1
#endif
#ifndef EPI_F32
#define EPI_F32 1
#endif
#ifndef SKIP_ATTN
#define SKIP_ATTN 0
#endif
#ifndef KV_TEST
#define KV_TEST 0
#endif
#ifndef REP_KVONLY
#define REP_KVONLY 0
#endif
#ifndef PH_MASK
#define PH_MASK 0xFFFF
#endif
#ifndef REP_MASK
#define REP_MASK 0
#endif
#define XSYNC() xcd_barrier(xbar)
#define PH(k) for (int rep_ = 0; rep_ < 1 + ((REP_MASK >> (k)) & 1); ++rep_) if (rep_ == 0 || grid_sync_fn(grid)) if constexpr ((PH_MASK >> (k)) & 1)
#define GRID_SYNC() do { asm volatile("s_waitcnt vmcnt(0) lgkmcnt(0)" ::: "memory"); __builtin_amdgcn_fence(__ATOMIC_RELEASE, "workgroup"); grid.sync(); } while (0)

typedef float f32x2_t __attribute__((ext_vector_type(2))); typedef __bf16 bf16x2_t __attribute__((ext_vector_type(2)));
__device__ __forceinline__ unsigned cvt_pk_bf16(float lo, float hi) { const f32x2_t v = {lo, hi}; const bf16x2_t b = __builtin_convertvector(v, bf16x2_t); return __builtin_bit_cast(unsigned, b); }
__device__ __forceinline__ float bf_lo(unsigned w) { return __uint_as_float(w << 16); }
__device__ __forceinline__ float bf_hi(unsigned w) { return __uint_as_float(w & 0xffff0000u); }
__device__ __forceinline__ float bf1(bf16_t b) { return __uint_as_float(((unsigned)b) << 16); }
__device__ __forceinline__ bf16_t f2bf(float f) { return (bf16_t)(cvt_pk_bf16(f, 0.f) & 0xffffu); }
__device__ __forceinline__ float wave_sum(float v) {
#pragma unroll
    for (int o = 1; o < 64; o <<= 1) v += __shfl_xor(v, o);
    return v;
}
__device__ __forceinline__ float half_swap_sum(float v) { auto rr = __builtin_amdgcn_permlane32_swap(__float_as_uint(v), __float_as_uint(v), false, false); return __uint_as_float(rr[0]) + __uint_as_float(rr[1]); }
__device__ __forceinline__ float half_swap_max(float v) { auto rr = __builtin_amdgcn_permlane32_swap(__float_as_uint(v), __float_as_uint(v), false, false); return fmaxf(__uint_as_float(rr[0]), __uint_as_float(rr[1])); }
__device__ __forceinline__ int fresh_tid() { int t = threadIdx.x; asm volatile("" : "+v"(t)); return t; }
__device__ __forceinline__ float max3f(float a, float b, float c) { float r; asm("v_max3_f32 %0, %1, %2, %3" : "=v"(r) : "v"(a), "v"(b), "v"(c)); return r; }
__device__ __forceinline__ int crow(int r, int hi) { return (r & 3) + 8 * (r >> 2) + 4 * hi; }
__device__ __forceinline__ float fast_silu(float g) { return g * __builtin_amdgcn_rcpf(1.0f + __builtin_amdgcn_exp2f(-1.4426950408889634f * g)); }
__device__ __forceinline__ s16x4 tr_read(const lds_t* p) { typedef short v4i16_t __attribute__((ext_vector_type(4))); return __builtin_bit_cast(s16x4, __builtin_amdgcn_ds_read_tr16_b64_v4i16((LAS v4i16_t*)p)); }
template <int SO> __device__ __forceinline__ bf16x8 tr_frag(const lds_t* a, int pitch) {
    const s16x4 lo = tr_read(a), h4 = tr_read(a + SO * pitch);
    return (bf16x8){lo[0], lo[1], lo[2], lo[3], h4[0], h4[1], h4[2], h4[3]};
}
__device__ __forceinline__ int tr_lane_off(int lane, int HM, int pitch) { return (HM * (lane >> 5) + ((lane & 15) >> 2)) * pitch + (16 * ((lane >> 4) & 1) + 4 * (lane & 3)) * 2; }
__device__ __forceinline__ bf16x8 pack8(float a0, float a1, float a2, float a3, float a4, float a5, float a6, float a7) {
    u32x4 w; w.x = cvt_pk_bf16(a0, a1); w.y = cvt_pk_bf16(a2, a3); w.z = cvt_pk_bf16(a4, a5); w.w = cvt_pk_bf16(a6, a7); return __builtin_bit_cast(bf16x8, w);
}
#define MFMA32(a, b, c) __builtin_amdgcn_mfma_f32_32x32x16_bf16((a), (b), (c), 0, 0, 0)

namespace pg8 {
constexpr int BM = 256, BK = 64, HALF = 128, HTB = HALF * BK * 2, STAGE_BYTES = 8 * HTB, NXCD = 8, WGM = 4;
__host__ __device__ __forceinline__ int lds_byte(int r, int c) { const int st = (r >> 4) * 2 + (c >> 5), rr = r & 15, cc = c & 31, ob = rr * 64 + cc * 2; return st * 1024 + (ob ^ (((ob >> 9) & 1) << 5)); }
__host__ __device__ __forceinline__ void stage_rc(int b, int& R, int& C) { const int st = b / 1024, sb = b % 1024, swz = sb ^ (((sb >> 9) & 1) << 5); R = (st >> 1) * 16 + swz / 64; C = (st & 1) * 32 + (swz % 64) / 2; }
__host__ __device__ __forceinline__ int perm32(int rho) { const int n = rho >> 4, i = rho & 15; return 8 * (i >> 2) + 4 * n + (i & 3); }
struct Unit { int pm, pn, kc; };
struct Gemm { const bf16_t* A; const bf16_t* Bt; int M, N, K, KL; };
struct StaticOrder {
    int nM, nN, nwg, G, c;
    __device__ void init(int M, int N, int G_, int c_) { nM = M / BM; nN = N / BM; nwg = nM * nN; G = G_; c = c_; }
    __device__ bool next(int i, Unit& u) const {
        const long L = (long)i * G + c; if (L >= nwg) return false;
        int wgid = (int)L; { const int q = nwg / NXCD, r = nwg % NXCD, xcd = wgid % NXCD, off = wgid / NXCD; wgid = (xcd < r ? xcd * (q + 1) : r * (q + 1) + (xcd - r) * q) + off; }
        const int nig = WGM * nN, gid = wgid / nig, fm = gid * WGM, gsz = (nM - fm) < WGM ? (nM - fm) : WGM;
        u.pm = fm + ((wgid % nig) % gsz); u.pn = (wgid % nig) / gsz; u.kc = 0; return true;
    }
};
struct SplitOrder {
    int nM, nN, nK, G, c;
    __device__ void init(int M, int N, int nK_, int G_, int c_) { nM = M / BM; nN = N / BM; nK = nK_; G = G_; c = c_; }
    __device__ bool next(int i, Unit& u) const {
        const int L = i * G + c; if (L >= nM * nN * nK) return false;
        u.kc = L % nK; const int t = L / nK; u.pn = t % nN; u.pm = t / nN; return true;
    }
};
struct Order4 {
    int nM, G, c;
    __device__ void init(int M, int G_, int c_) { nM = M / BM; G = G_; c = c_; }
    __device__ bool next(int i, Unit& u) const {
        if ((G & 31) == 0) { const int per = G >> 2, x = c & 7, j = c >> 3; u.pm = i * per + x * (per >> 3) + (j >> 2); u.pn = j & 3; }
        else { const int L = i * G + c; u.pm = L >> 2; u.pn = L & 3; }
        u.kc = 0; return u.pm < nM;
    }
};
template <class Epi, class Sched>
__device__ __forceinline__ void gemm_phase(lds_t* lds, const Gemm g, const Sched& S, const Epi& E) {
    int tid = threadIdx.x; asm volatile("" : "+v"(tid));
    const int wid = __builtin_amdgcn_readfirstlane(tid >> 6), lane = tid & 63, wr = wid >> 2, wc = wid & 3, fr = lane & 15, fq = lane >> 4;
    const int K = g.K, nt = g.KL / BK;
    const size_t kcstep = (size_t)g.KL * 2;
    unsigned voffA[2], voffB[2];
#pragma unroll
    for (int i = 0; i < 2; ++i) { int R, C; stage_rc(tid * 16 + i * 8192, R, C); const int Rb = (R & ~31) + perm32(R & 31);
        voffA[i] = (unsigned)(R * K + C) * 2u; voffB[i] = (unsigned)(Rb * K + C) * 2u; }
    const size_t kstep = (size_t)(BK * 2);
    const size_t hstep = (size_t)HALF * K * 2;
    const size_t tstep = 2 * hstep;
    const unsigned ldsw = (unsigned)wid * 1024u;
    const int aoff = lds_byte(wr * 64 + fr, fq * 8), boff = lds_byte(wc * 32 + fr, fq * 8);
#define PG8_SA(b, h) (((b) * 2 + (h)) * HTB)
#define PG8_SB(b, h) ((4 + (b) * 2 + (h)) * HTB)
#define PG8_STAGE(bufoff, gbase, voff) do { _Pragma("unroll") for (int _i = 0; _i < 2; ++_i) \
        __builtin_amdgcn_global_load_lds((const unsigned*)((const char*)(gbase) + (voff)[_i]), (LAS unsigned*)(lds + (bufoff) + ldsw + _i * 8192), 16, 0, 0); } while (0)
#define PG8_LDA(dst, b, h) do { _Pragma("unroll") for (int m = 0; m < 4; ++m) _Pragma("unroll") for (int k = 0; k < 2; ++k) dst[m][k] = *(const LAS bf16x8*)(lds + PG8_SA(b, h) + aoff + m * 2048 + k * 1024); } while (0)
#define PG8_LDB(dst, b, h) do { _Pragma("unroll") for (int n = 0; n < 2; ++n) _Pragma("unroll") for (int k = 0; k < 2; ++k) dst[n][k] = *(const LAS bf16x8*)(lds + PG8_SB(b, h) + boff + n * 2048 + k * 1024); } while (0)
#define PG8_MMA(ai, bj, At, Bt) do { __builtin_amdgcn_s_setprio(1); _Pragma("unroll") for (int m = 0; m < 4; ++m) _Pragma("unroll") for (int n = 0; n < 2; ++n) _Pragma("unroll") for (int k = 0; k < 2; ++k) \
        acc[ai][bj][m][n] = __builtin_amdgcn_mfma_f32_16x16x32_bf16(Bt[n][k], At[m][k], acc[ai][bj][m][n], 0, 0, 0); __builtin_amdgcn_s_setprio(0); } while (0)
#define PG8_WAIT_V(n) asm volatile("s_waitcnt vmcnt(" #n ")" ::: "memory")
#define PG8_WAIT_L(n) asm volatile("s_waitcnt lgkmcnt(" #n ")" ::: "memory")
#define PG8_BAR __builtin_amdgcn_s_barrier()
#define PG8_SCHED __builtin_amdgcn_sched_barrier(0)
    Unit cur, nxt; int ui = 0;
    if (!S.next(0, cur)) return;
    f32x4 acc[2][2][4][2];
#pragma unroll
    for (int a = 0; a < 2; ++a)
#pragma unroll
        for (int b = 0; b < 2; ++b)
#pragma unroll
            for (int m = 0; m < 4; ++m)
#pragma unroll
                for (int n = 0; n < 2; ++n) acc[a][b][m][n] = (f32x4){0.f, 0.f, 0.f, 0.f};
    bf16x8 At[4][2], B0[2][2], B1[2][2];
    const char* cA = (const char*)g.A + (size_t)cur.pm * tstep + (size_t)cur.kc * kcstep; const char* cB = (const char*)g.Bt + (size_t)cur.pn * tstep + (size_t)cur.kc * kcstep;
    PG8_STAGE(PG8_SB(0, 0), cB, voffB); PG8_STAGE(PG8_SB(0, 1), cB + hstep, voffB); PG8_STAGE(PG8_SA(0, 0), cA, voffA); PG8_STAGE(PG8_SA(0, 1), cA + hstep, voffA);
    if (wr == 1) PG8_BAR;
    PG8_WAIT_V(2); PG8_BAR;
    PG8_STAGE(PG8_SB(1, 0), cB + kstep, voffB); PG8_STAGE(PG8_SA(1, 0), cA + kstep, voffA); PG8_STAGE(PG8_SB(1, 1), cB + hstep + kstep, voffB);
    PG8_WAIT_V(6); PG8_BAR;
    for (;;) {
        const bool has_next = S.next(ui + 1, nxt);
        const char* nA = has_next ? (const char*)g.A + (size_t)nxt.pm * tstep + (size_t)nxt.kc * kcstep : cA; const char* nB = has_next ? (const char*)g.Bt + (size_t)nxt.pn * tstep + (size_t)nxt.kc * kcstep : cB;
        for (int t = 0; t < nt; t += 2) {
            const bool last = (t == nt - 2);
            const char* a1 = cA + (size_t)(t + 1) * kstep;
            const char* a2 = last ? nA : cA + (size_t)(t + 2) * kstep; const char* b2 = last ? nB : cB + (size_t)(t + 2) * kstep;
            const char* a3 = a2 + kstep; const char* b3 = b2 + kstep;
            PG8_LDB(B0, 0, 0); PG8_LDB(B1, 0, 1); PG8_SCHED; PG8_LDA(At, 0, 0); PG8_STAGE(PG8_SA(1, 1), a1 + hstep, voffA);
            PG8_WAIT_V(8); PG8_WAIT_L(0); PG8_BAR; PG8_MMA(0, 0, At, B0); PG8_MMA(0, 1, At, B1); PG8_BAR; PG8_SCHED;
            PG8_LDA(At, 0, 1); PG8_STAGE(PG8_SB(0, 0), b2, voffB); PG8_STAGE(PG8_SB(0, 1), b2 + hstep, voffB); PG8_STAGE(PG8_SA(0, 0), a2, voffA);
            PG8_WAIT_V(8); PG8_WAIT_L(0); PG8_BAR; PG8_MMA(1, 0, At, B0); PG8_MMA(1, 1, At, B1); PG8_BAR; PG8_SCHED;
            PG8_LDB(B0, 1, 0); PG8_LDB(B1, 1, 1); PG8_SCHED; PG8_LDA(At, 1, 0); PG8_STAGE(PG8_SA(0, 1), a2 + hstep, voffA);
            PG8_WAIT_V(8); PG8_WAIT_L(0); PG8_BAR; PG8_MMA(0, 0, At, B0); PG8_MMA(0, 1, At, B1); PG8_BAR; PG8_SCHED;
            PG8_LDA(At, 1, 1); PG8_STAGE(PG8_SB(1, 0), b3, voffB); PG8_STAGE(PG8_SB(1, 1), b3 + hstep, voffB); PG8_STAGE(PG8_SA(1, 0), a3, voffA);
            PG8_WAIT_V(8); PG8_WAIT_L(0); PG8_BAR; PG8_MMA(1, 0, At, B0); PG8_MMA(1, 1, At, B1); PG8_BAR; PG8_SCHED;
        }
        if (wr == 0) PG8_BAR;
        PG8_SCHED; asm volatile("" ::: "memory"); E(acc, cur, wr, wc, fr, fq); asm volatile("" ::: "memory"); PG8_SCHED;
        if (!has_next) break;
#pragma unroll
        for (int a = 0; a < 2; ++a)
#pragma unroll
            for (int b = 0; b < 2; ++b)
#pragma unroll
                for (int m = 0; m < 4; ++m)
#pragma unroll
                    for (int n = 0; n < 2; ++n) acc[a][b][m][n] = (f32x4){0.f, 0.f, 0.f, 0.f};
        cur = nxt; cA = nA; cB = nB; ++ui;
        if (wr == 1) PG8_BAR;
    }
    PG8_WAIT_V(0);
    PG8_BAR;
#undef PG8_SA
#undef PG8_SB
#undef PG8_STAGE
#undef PG8_LDA
#undef PG8_LDB
#undef PG8_MMA
#undef PG8_WAIT_V
#undef PG8_WAIT_L
#undef PG8_BAR
#undef PG8_SCHED
}
}

struct EpiSwiglu {
    bf16_t* O;
    __device__ __forceinline__ void operator()(const f32x4 (&acc)[2][2][4][2], const pg8::Unit& u, int wr, int wc, int fr, int fq) const {
        const int row0 = u.pm * 256 + wr * 64 + fr, col0 = u.pn * 128 + wc * 32 + 8 * fq;
#pragma unroll
        for (int ai = 0; ai < 2; ++ai)
#pragma unroll
            for (int m = 0; m < 4; ++m) {
                bf16_t* rowp = O + (size_t)(row0 + ai * 128 + m * 16) * DFF + col0;
                const f32x4 g0 = acc[ai][0][m][0], g1 = acc[ai][0][m][1], u0 = acc[ai][1][m][0], u1 = acc[ai][1][m][1];
                u32x4 w;
                w.x = cvt_pk_bf16(fast_silu(g0[0]) * u0[0], fast_silu(g0[1]) * u0[1]); w.y = cvt_pk_bf16(fast_silu(g0[2]) * u0[2], fast_silu(g0[3]) * u0[3]);
                w.z = cvt_pk_bf16(fast_silu(g1[0]) * u1[0], fast_silu(g1[1]) * u1[1]); w.w = cvt_pk_bf16(fast_silu(g1[2]) * u1[2], fast_silu(g1[3]) * u1[3]);
                *(u32x4*)rowp = w;
            }
    }
};
struct EpiD {
    bf16_t* O;
    __device__ __forceinline__ void operator()(const f32x4 (&acc)[2][2][4][2], const pg8::Unit& u, int wr, int wc, int fr, int fq) const {
        const int row0 = u.pm * 256 + wr * 64 + fr, col0 = u.pn * 256 + wc * 32 + 8 * fq;
#pragma unroll
        for (int ai = 0; ai < 2; ++ai)
#pragma unroll
            for (int m = 0; m < 4; ++m) {
                bf16_t* rowp = O + (size_t)(row0 + ai * 128 + m * 16) * DM + col0;
#pragma unroll
                for (int bj = 0; bj < 2; ++bj) { const f32x4 v0 = acc[ai][bj][m][0], v1 = acc[ai][bj][m][1];
                    u32x4 w; w.x = cvt_pk_bf16(v0[0], v0[1]); w.y = cvt_pk_bf16(v0[2], v0[3]); w.z = cvt_pk_bf16(v1[0], v1[1]); w.w = cvt_pk_bf16(v1[2], v1[3]);
                    *(u32x4*)(rowp + bj * 128) = w; }
            }
    }
};
struct RowStat { float* slots; unsigned* cnt; };
#define RLX_AGENT __ATOMIC_RELAXED, __HIP_MEMORY_SCOPE_AGENT
__device__ __forceinline__ void rowstat_exchange(const f32x4 (&v)[2][2][4][2], const RowStat& st, int pm, int pn, lds_t* tab, int wr, int wc, int fr, int fq, int tid, int wid, int lane) {
    LAS float* Pt = (LAS float*)tab;
    LAS float* St = (LAS float*)(tab + 4096);
#pragma unroll
    for (int ai = 0; ai < 2; ++ai)
#pragma unroll
        for (int m = 0; m < 4; ++m) {
            float s = 0.f;
#pragma unroll
            for (int bj = 0; bj < 2; ++bj)
#pragma unroll
                for (int n = 0; n < 2; ++n) { const f32x4 x = v[ai][bj][m][n]; s += (x[0] * x[0] + x[1] * x[1]) + (x[2] * x[2] + x[3] * x[3]); }
            s += __shfl_xor(s, 16); s += __shfl_xor(s, 32);
            if (fq == 0) Pt[(ai * 128 + wr * 64 + m * 16 + fr) * 4 + wc] = s;
        }
    asm volatile("s_waitcnt lgkmcnt(0)" ::: "memory"); __builtin_amdgcn_s_barrier(); asm volatile("" ::: "memory");
    if (tid < 256) {
        const float tot = (Pt[tid * 4 + 0] + Pt[tid * 4 + 1]) + (Pt[tid * 4 + 2] + Pt[tid * 4 + 3]);
        __hip_atomic_store((unsigned*)(st.slots + ((size_t)pm * 256 + tid) * 4 + pn), __float_as_uint(tot), RLX_AGENT);
    }
    asm volatile("s_waitcnt vmcnt(0)" ::: "memory");
    if (wid < 4 && lane == 0) __hip_atomic_fetch_add(st.cnt + 64 * pm, 1u, RLX_AGENT);
    if (wid == 0) {
        unsigned spins = 0;
        while ((unsigned)__builtin_amdgcn_readfirstlane(__hip_atomic_load(st.cnt + 64 * pm, RLX_AGENT)) < 16u) { __builtin_amdgcn_s_sleep(2); if (++spins > 400000u) break; }
        __builtin_amdgcn_fence(__ATOMIC_ACQUIRE, "agent");
    }
    asm volatile("s_waitcnt vmcnt(0) lgkmcnt(0)" ::: "memory"); __builtin_amdgcn_s_barrier(); asm volatile("" ::: "memory");
    if (tid < 256) {
        const unsigned* sl = (const unsigned*)(st.slots + ((size_t)pm * 256 + tid) * 4);
        const float t = (__uint_as_float(__hip_atomic_load(sl + 0, RLX_AGENT)) + __uint_as_float(__hip_atomic_load(sl + 1, RLX_AGENT))) +
                        (__uint_as_float(__hip_atomic_load(sl + 2, RLX_AGENT)) + __uint_as_float(__hip_atomic_load(sl + 3, RLX_AGENT)));
        St[tid] = __builtin_amdgcn_rsqf(t * (1.0f / DM) + EPS);
    }
    asm volatile("s_waitcnt vmcnt(0) lgkmcnt(0)" ::: "memory"); __builtin_amdgcn_s_barrier(); asm volatile("" ::: "memory");
}
template <bool SRC_BF, int GB>
__device__ __forceinline__ void load_xbatch(const void* xs_, size_t off0, int g0, u32x4 (&xb)[4][2], f32x4 (&xf)[2][2][2]) {
#pragma unroll
    for (int k = 0; k < GB; ++k) { const int gg = g0 + k; const size_t o_ = off0 + (size_t)((gg >> 2) * 128 + (gg & 3) * 16) * DM;
#pragma unroll
        for (int bj = 0; bj < 2; ++bj) {
            if (SRC_BF) xb[k][bj] = *(const u32x4*)((const bf16_t*)xs_ + o_ + bj * 128);
            else { xf[k & 1][bj][0] = *(const f32x4*)((const float*)xs_ + o_ + bj * 128); xf[k & 1][bj][1] = *(const f32x4*)((const float*)xs_ + o_ + bj * 128 + 4); }
        } }
}
template <bool SRC_BF, bool DST_BF>
struct EpiResNorm {
    const void* xsrc; void* X; bf16_t* H; const float* gpost; const float* gpre; float scale; RowStat st1, st2; lds_t* lds;
    __device__ __forceinline__ void operator()(f32x4 (&acc)[2][2][4][2], const pg8::Unit& u, int wr, int wc, int fr, int fq) const {
        const int tid = fresh_tid(), lane = tid & 63, wid = __builtin_amdgcn_readfirstlane(tid >> 6);
        const int cb = u.pn * 256 + wc * 32 + 8 * fq;
        const size_t off0 = (size_t)(u.pm * 256 + wr * 64 + fr) * DM + cb;
        constexpr int GB = SRC_BF ? 4 : 2;
        u32x4 xb[4][2]; f32x4 xf[2][2][2];
        f32x4 g[2][2];
        float sc1_ = scale; asm volatile("" : "+v"(sc1_)); const f32x4 scv = {sc1_, sc1_, sc1_, sc1_};
#pragma unroll
        for (int bj = 0; bj < 2; ++bj)
#pragma unroll
            for (int n = 0; n < 2; ++n) g[bj][n] = *(const f32x4*)(gpost + cb + bj * 128 + 4 * n) * scv;
        load_xbatch<SRC_BF, GB>(xsrc, off0, 0, xb, xf);
        rowstat_exchange(acc, st1, u.pm, u.pn, lds + LDS_TAB, wr, wc, fr, fq, tid, wid, lane);
        const LAS float* St = (const LAS float*)(lds + LDS_TAB + 4096);
#pragma unroll
        for (int gq = 0; gq < 8; ++gq) {
            const int ai = gq >> 2, m = gq & 3, k = gq % GB;
            if (gq != 0 && k == 0) load_xbatch<SRC_BF, GB>(xsrc, off0, gq, xb, xf);
            const int rl = ai * 128 + wr * 64 + m * 16 + fr; const float rs = St[rl];
            const size_t off = off0 + (size_t)(ai * 128 + m * 16) * DM;
#pragma unroll
            for (int bj = 0; bj < 2; ++bj) {
                f32x4 x0, x1;
                if (SRC_BF) { const u32x4 w = xb[k][bj];
                    x0 = (f32x4){bf_lo(w.x), bf_hi(w.x), bf_lo(w.y), bf_hi(w.y)}; x1 = (f32x4){bf_lo(w.z), bf_hi(w.z), bf_lo(w.w), bf_hi(w.w)}; }
                else { x0 = xf[k & 1][bj][0]; x1 = xf[k & 1][bj][1]; }
                x0 = x0 + acc[ai][bj][m][0] * g[bj][0] * rs; x1 = x1 + acc[ai][bj][m][1] * g[bj][1] * rs;
                acc[ai][bj][m][0] = x0; acc[ai][bj][m][1] = x1;
                if (DST_BF) { u32x4 w; w.x = cvt_pk_bf16(x0[0], x0[1]); w.y = cvt_pk_bf16(x0[2], x0[3]); w.z = cvt_pk_bf16(x1[0], x1[1]); w.w = cvt_pk_bf16(x1[2], x1[3]);
                    *(u32x4*)((bf16_t*)X + off + bj * 128) = w; }
                else { *(f32x4*)((float*)X + off + bj * 128) = x0; *(f32x4*)((float*)X + off + bj * 128 + 4) = x1; }
            }
        }
        if (H) {
            rowstat_exchange(acc, st2, u.pm, u.pn, lds + LDS_TAB + 5120, wr, wc, fr, fq, tid, wid, lane);
            const LAS float* S2 = (const LAS float*)(lds + LDS_TAB + 5120 + 4096);
#pragma unroll
            for (int bj = 0; bj < 2; ++bj)
#pragma unroll
                for (int n = 0; n < 2; ++n) g[bj][n] = *(const f32x4*)(gpre + cb + bj * 128 + 4 * n);
#pragma unroll
            for (int ai = 0; ai < 2; ++ai)
#pragma unroll
                for (int m = 0; m < 4; ++m) {
                    const int rl = ai * 128 + wr * 64 + m * 16 + fr; const float rs = S2[rl];
                    bf16_t* hp = H + (size_t)(u.pm * 256 + rl) * DM + cb;
#pragma unroll
                    for (int bj = 0; bj < 2; ++bj) { const f32x4 h0 = acc[ai][bj][m][0] * g[bj][0] * rs, h1 = acc[ai][bj][m][1] * g[bj][1] * rs;
                        u32x4 w; w.x = cvt_pk_bf16(h0[0], h0[1]); w.y = cvt_pk_bf16(h0[2], h0[3]); w.z = cvt_pk_bf16(h1[0], h1[1]); w.w = cvt_pk_bf16(h1[2], h1[3]);
                        *(u32x4*)(hp + bj * 128) = w; }
                }
        }
    }
};
struct EpiPart {
    float* O;
    __device__ __forceinline__ void operator()(const f32x4 (&acc)[2][2][4][2], const pg8::Unit& u, int wr, int wc, int fr, int fq) const {
        const int row0 = u.pm * 256 + wr * 64 + fr, col0 = u.pn * 256 + wc * 32 + 8 * fq;
        float* base = O + (size_t)u.kc * TS * DM;
#pragma unroll
        for (int ai = 0; ai < 2; ++ai)
#pragma unroll
            for (int m = 0; m < 4; ++m) {
                float* rowp = base + (size_t)(row0 + ai * 128 + m * 16) * DM + col0;
#pragma unroll
                for (int bj = 0; bj < 2; ++bj) { *(f32x4*)(rowp + bj * 128) = acc[ai][bj][m][0]; *(f32x4*)(rowp + bj * 128 + 4) = acc[ai][bj][m][1]; }
            }
    }
};
__device__ __forceinline__ int win_srccol(int nd) {
    const int pn = nd >> 8, dc = nd & 255, sec = pn >> 1, base = sec * 512 + (pn & 1) * 256, bj = dc >> 7, wc = (dc >> 5) & 3, w = dc & 31;
    if (sec == 0 || sec == 1) return base + 128 * (wc >> 1) + 64 * bj + 32 * (wc & 1) + w;
    if (sec == 4 || sec == 5) { const int dim = (w < 8) ? (bj * 8 + w) : (16 + 24 * bj + (w - 8)); return base + 64 * wc + dim; }
    return base + dc;
}
struct EpiIn {
    bf16_t* P; float* out; const float* RT; const float* DT;
    __device__ __forceinline__ void operator()(const f32x4 (&acc)[2][2][4][2], const pg8::Unit& u, int wr, int wc, int fr, int fq) const {
        const int sec = u.pn >> 1, base = sec * 512 + (u.pn & 1) * 256;
        const int row0 = u.pm * 256 + wr * 64 + fr;
        int c0, c1, toff;
        const float* tab; int tstride;
        bool rot;
        if (sec == 0 || sec == 1) { c0 = base + 128 * (wc >> 1) + 32 * (wc & 1) + 8 * fq; c1 = c0 + 64; tab = RT; tstride = 128; toff = (32 * (wc & 1) + 8 * fq) * 2; rot = true; }
        else if (sec == 4 || sec == 5) { if (fq == 0) { c0 = base + 64 * wc; c1 = c0 + 8; } else { c0 = base + 64 * wc + 8 + 8 * fq; c1 = c0 + 24; } tab = RT; tstride = 16; toff = (int)((WS_DT - WS_RT) / 4); rot = (fq == 0); }
        else { c0 = base + 32 * wc + 8 * fq; c1 = c0 + 128; tab = RT; tstride = 0; toff = 0; rot = false; }
        const float sc = sec == 1 ? KRSCALE : (sec == 4 ? QSCALE : 1.0f);
        const bool f32o = sec >= 5;
        const int oc0 = c0 - sec * 512, oc1 = c1 - sec * 512;
        f32x4 cur[4], nx1[4], dlt[4];
        auto load_tab = [&](int pos, f32x4 (&tv)[4]) {
            const f32x4* tp = (const f32x4*)(tab + (size_t)pos * tstride + toff);
            tv[0] = tp[0]; tv[1] = tp[1]; tv[2] = tp[2]; tv[3] = tp[3];
        };
        if (rot) {
            const int r_a = row0, r_b = row0 + 128;
            load_tab(r_a < TP ? (r_a & (SEQ - 1)) : PAST + ((r_a - TP) & (DSEQ - 1)), cur);
            load_tab(r_b < TP ? (r_b & (SEQ - 1)) : PAST + ((r_b - TP) & (DSEQ - 1)), nx1);
            load_tab(16, dlt);
        }
#pragma unroll
        for (int g = 0; g < 8; ++g) {
            const int ai = g >> 2, m = g & 3;
            if (rot) {
                if (g == 4) {
#pragma unroll
                    for (int k = 0; k < 4; ++k) cur[k] = nx1[k];
                } else if (m != 0) {
#pragma unroll
                    for (int k = 0; k < 4; ++k) { const f32x4 cs = cur[k], d = dlt[k];
                        cur[k] = (f32x4){cs[0] * d[0] - cs[1] * d[1], cs[1] * d[0] + cs[0] * d[1], cs[2] * d[2] - cs[3] * d[3], cs[3] * d[2] + cs[2] * d[3]}; }
                }
            }
            f32x4 tv[4];
#pragma unroll
            for (int k = 0; k < 4; ++k) tv[k] = cur[k];
            const int row = row0 + ai * 128 + m * 16;
            bf16_t* rowp = P + (size_t)row * NIN;
            float* ob = out + (sec == 5 ? (row < TP ? OK_P : OK_S) : (row < TP ? OV_P : OV_S)) + (size_t)(row < TP ? row : row - TP) * 512;
            u32x4 wa, wb;
#pragma unroll
            for (int n = 0; n < 2; ++n) {
                f32x4 a = acc[ai][0][m][n], b = acc[ai][1][m][n];
                if (rot) {
                    const f32x4 t0 = tv[2 * n], t1 = tv[2 * n + 1];
                    f32x4 x, y;
                    x[0] = a[0] * t0[0] - b[0] * t0[1]; y[0] = b[0] * t0[0] + a[0] * t0[1];
                    x[1] = a[1] * t0[2] - b[1] * t0[3]; y[1] = b[1] * t0[2] + a[1] * t0[3];
                    x[2] = a[2] * t1[0] - b[2] * t1[1]; y[2] = b[2] * t1[0] + a[2] * t1[1];
                    x[3] = a[3] * t1[2] - b[3] * t1[3]; y[3] = b[3] * t1[2] + a[3] * t1[3];
                    a = x; b = y;
                }
                if (f32o) { *(f32x4*)(ob + oc0 + 4 * n) = a; *(f32x4*)(ob + oc1 + 4 * n) = b; }
                a *= sc; b *= sc;
                if (n == 0) { wa.x = cvt_pk_bf16(a[0], a[1]); wa.y = cvt_pk_bf16(a[2], a[3]); wb.x = cvt_pk_bf16(b[0], b[1]); wb.y = cvt_pk_bf16(b[2], b[3]); }
                else { wa.z = cvt_pk_bf16(a[0], a[1]); wa.w = cvt_pk_bf16(a[2], a[3]); wb.z = cvt_pk_bf16(b[0], b[1]); wb.w = cvt_pk_bf16(b[2], b[3]); }
            }
            *(u32x4*)(rowp + c0) = wa; *(u32x4*)(rowp + c1) = wb;
        }
    }
};

struct Params { const float* in[25]; float* out; unsigned char* ws; };

template <class F>
__device__ __forceinline__ void transpose_item(const float* W, int K, int Nsrc, bf16_t* WT, LAS float* scr, int k0, int n0, int lane, F srccol) {
    const int sc = srccol(n0 + (lane & 31));
#pragma unroll
    for (int i = 0; i < 32; ++i) { const int kk = 2 * i + (lane >> 5); scr[kk * 33 + (lane & 31)] = W[(size_t)(k0 + kk) * Nsrc + sc]; }
    asm volatile("s_waitcnt lgkmcnt(0)" ::: "memory");
    const int c = lane & 7;
#pragma unroll
    for (int j = 0; j < 4; ++j) { const int n = (lane >> 3) + 8 * j; const LAS float* s = scr + (8 * c) * 33 + n;
        u32x4 o; o.x = cvt_pk_bf16(s[0 * 33], s[1 * 33]); o.y = cvt_pk_bf16(s[2 * 33], s[3 * 33]); o.z = cvt_pk_bf16(s[4 * 33], s[5 * 33]); o.w = cvt_pk_bf16(s[6 * 33], s[7 * 33]);
        *(u32x4*)(WT + (size_t)(n0 + n) * K + k0 + 8 * c) = o; }
    asm volatile("s_waitcnt lgkmcnt(0)" ::: "memory");
}
__device__ __forceinline__ void row_phase(const float* xp, const float* xs, const bf16_t* D, const float* PART, int nk, const float* gpost, float scale, float* X, const float* gpre, bf16_t* H, int gw, int ngw, int r0 = 0) {
    const int lane = fresh_tid() & 63;
    for (int rowa = r0 + gw; rowa < T; rowa += 2 * ngw) {
        const int rowb = rowa + ngw; const bool hasb = rowb < T;
        f32x4 v[2][4]; u32x2 dw[2][4];
#pragma unroll
        for (int k = 0; k < 2; ++k) { const int row = k ? rowb : rowa;
            if (k == 0 || hasb) {
                const float* xr = row < TP ? xp + (size_t)row * DM : xs + (size_t)(row - TP) * DM;
#pragma unroll
                for (int j = 0; j < 4; ++j) v[k][j] = *(const f32x4*)(xr + 4 * lane + 256 * j);
                if (D && row < TP) {
#pragma unroll
                    for (int j = 0; j < 4; ++j) dw[k][j] = *(const u32x2*)(D + (size_t)row * DM + 4 * lane + 256 * j);
                }
            } }
#pragma unroll
        for (int k = 0; k < 2; ++k) { const int row = k ? rowb : rowa;
            if (k == 0 || hasb) {
                if (D) {
                    f32x4 d[4]; float ss = 0.f;
#pragma unroll
                    for (int j = 0; j < 4; ++j) {
                        if (row < TP) { const u32x2 w = dw[k][j]; d[j] = (f32x4){bf_lo(w.x), bf_hi(w.x), bf_lo(w.y), bf_hi(w.y)}; }
                        else { d[j] = (f32x4){0.f, 0.f, 0.f, 0.f}; for (int kc = 0; kc < nk; ++kc) d[j] += *(const f32x4*)(PART + ((size_t)kc * TS + (row - TP)) * DM + 4 * lane + 256 * j); }
                        ss += (d[j][0] * d[j][0] + d[j][1] * d[j][1]) + (d[j][2] * d[j][2] + d[j][3] * d[j][3]); }
                    const float rs = scale * __builtin_amdgcn_rsqf(wave_sum(ss) * (1.0f / DM) + EPS);
#pragma unroll
                    for (int j = 0; j < 4; ++j) { const f32x4 g = *(const f32x4*)(gpost + 4 * lane + 256 * j); v[k][j] = v[k][j] + d[j] * g * rs; *(f32x4*)(X + (size_t)row * DM + 4 * lane + 256 * j) = v[k][j]; }
                }
                if (gpre) {
                    float ss = 0.f;
#pragma unroll
                    for (int j = 0; j < 4; ++j) ss += (v[k][j][0] * v[k][j][0] + v[k][j][1] * v[k][j][1]) + (v[k][j][2] * v[k][j][2] + v[k][j][3] * v[k][j][3]);
                    const float rs = __builtin_amdgcn_rsqf(wave_sum(ss) * (1.0f / DM) + EPS);
#pragma unroll
                    for (int j = 0; j < 4; ++j) { const f32x4 g = *(const f32x4*)(gpre + 4 * lane + 256 * j); const f32x4 h = v[k][j] * g * rs;
                        u32x2 w; w.x = cvt_pk_bf16(h[0], h[1]); w.y = cvt_pk_bf16(h[2], h[3]); *(u32x2*)(H + (size_t)row * DM + 4 * lane + 256 * j) = w; }
                }
            } }
    }
}

constexpr int KP = 272, VP = 320;
constexpr int KTB = 64 * KP, VTB = 64 * VP, TILEB = KTB + VTB;
__device__ __forceinline__ void attn_unit(lds_t* lds, const bf16_t* P, const bf16_t* KC, const bf16_t* VC, bf16_t* Y, const float* dg, float lam, int kind, int b, int h, int qb) {
    int tid = threadIdx.x; asm volatile("" : "+v"(tid));
    const int lane = tid & 63, wid = __builtin_amdgcn_readfirstlane(tid >> 6), ql = lane & 31, hi = lane >> 5, qg = wid >> 1, c = wid & 1;
    const int qrow0 = kind == 0 ? b * SEQ + qb * 128 : TP + b * DSEQ;
    const int NT = kind == 0 ? 2 * qb + 2 : 65;
    const bool active = kind == 0 ? true : (qg < 2);
    const int my_nt = kind == 0 ? 2 * qb + 1 + (qg >> 1) : (active ? 65 : 0);
    bf16x8 qf[4];
    {
        const bf16_t* qp = P + (size_t)(qrow0 + (active ? 32 * qg + ql : 0)) * NIN + 2048 + h * 128 + c * 64 + 8 * hi;
#pragma unroll
        for (int ks = 0; ks < 4; ++ks) qf[ks] = *(const bf16x8*)(qp + 16 * ks);
    }
    f32x16 o[4];
#pragma unroll
    for (int e = 0; e < 4; ++e)
#pragma unroll
        for (int r = 0; r < 16; ++r) o[e][r] = 0.f;
    float mref = 0.f, lsum = 0.f; f32x16 negm;
#pragma unroll
    for (int r = 0; r < 16; ++r) negm[r] = 0.f;
    asm volatile("" : "+v"(negm));
    const int srow0 = tid >> 4, sch = tid & 15;
    u32x4 kA[2], vA[2], kB[2], vB[2];
    auto load_tile = [&](int t, u32x4 (&kreg)[2], u32x4 (&vreg)[2]) {
        const bf16_t *kb, *vb; size_t pitch;
        if (kind == 0) { kb = P + (size_t)(b * SEQ + t * 64) * NIN + 2560 + h * 128; vb = kb + 512; pitch = NIN; }
        else if (t < 64) { kb = KC + (size_t)(b * PAST + t * 64) * 512 + h * 128; vb = VC + (size_t)(b * PAST + t * 64) * 512 + h * 128; pitch = 512; }
        else { kb = P + (size_t)(TP + b * DSEQ) * NIN + 2560 + h * 128; vb = kb + 512; pitch = NIN; }
#pragma unroll
        for (int i = 0; i < 2; ++i) { const int row = srow0 + 32 * i; kreg[i] = *(const u32x4*)(kb + row * pitch + sch * 8); vreg[i] = *(const u32x4*)(vb + row * pitch + sch * 8); }
    };
    auto store_tile = [&](int buf, const u32x4 (&kreg)[2], const u32x4 (&vreg)[2]) {
        lds_t* kl = lds + buf * TILEB; lds_t* vl = kl + KTB;
#pragma unroll
        for (int i = 0; i < 2; ++i) { const int row = srow0 + 32 * i; *(LAS u32x4*)(kl + row * KP + sch * 16) = kreg[i]; *(LAS u32x4*)(vl + row * VP + sch * 16) = vreg[i]; }
    };
    const int troff = tr_lane_off(lane, 4, VP);
    auto compute_tile = [&](int buf, bool first) {
        const lds_t* kl = lds + buf * TILEB; const lds_t* vl = kl + KTB;
        f32x16 s0, s1;
#pragma unroll
        for (int ks = 0; ks < 4; ++ks) {
            const bf16x8 a0 = *(const LAS bf16x8*)(kl + ql * KP + (c * 64 + 16 * ks + 8 * hi) * 2);
            const bf16x8 a1 = *(const LAS bf16x8*)(kl + (32 + ql) * KP + (c * 64 + 16 * ks + 8 * hi) * 2);
            if (ks == 0) { s0 = MFMA32(a0, qf[0], negm); s1 = MFMA32(a1, qf[0], negm); }
            else { s0 = MFMA32(a0, qf[ks], s0); s1 = MFMA32(a1, qf[ks], s1); }
        }
        asm volatile("s_nop 15\n\ts_nop 7" : "+v"(s0), "+v"(s1));
        float ma = max3f(s0[0], s0[1], s1[0]), mb = max3f(s0[2], s0[3], s1[1]); ma = max3f(ma, s1[2], s1[3]);
#pragma unroll
        for (int r = 4; r < 16; r += 4) { ma = max3f(ma, s0[r], s0[r + 1]); mb = max3f(mb, s0[r + 2], s0[r + 3]); ma = max3f(ma, s1[r], s1[r + 1]); mb = max3f(mb, s1[r + 2], s1[r + 3]); }
        const float rm = half_swap_max(fmaxf(ma, mb));
        if (first || __any(rm > 8.0f)) {
            const float dl = first ? rm : fmaxf(rm, 0.f);
            mref += dl;
#pragma unroll
            for (int r = 0; r < 16; ++r) { s0[r] -= dl; s1[r] -= dl; negm[r] = -mref; }
            asm volatile("" : "+v"(negm));
            if (!first) { const float f = __builtin_amdgcn_exp2f(-dl); lsum *= f;
#pragma unroll
                for (int e = 0; e < 4; ++e)
#pragma unroll
                    for (int r = 0; r < 16; ++r) o[e][r] *= f; }
        }
        float ps = 0.f;
#pragma unroll
        for (int r = 0; r < 16; ++r) { s0[r] = __builtin_amdgcn_exp2f(s0[r]); s1[r] = __builtin_amdgcn_exp2f(s1[r]); ps += s0[r] + s1[r]; }
        lsum += ps;
        bf16x8 pf[4];
        pf[0] = pack8(s0[0], s0[1], s0[2], s0[3], s0[4], s0[5], s0[6], s0[7]);
        pf[1] = pack8(s0[8], s0[9], s0[10], s0[11], s0[12], s0[13], s0[14], s0[15]);
        pf[2] = pack8(s1[0], s1[1], s1[2], s1[3], s1[4], s1[5], s1[6], s1[7]);
        pf[3] = pack8(s1[8], s1[9], s1[10], s1[11], s1[12], s1[13], s1[14], s1[15]);
#pragma unroll
        for (int ks = 0; ks < 4; ++ks) {
#pragma unroll
            for (int e = 0; e < 4; ++e) { const bf16x8 a = tr_frag<8>(vl + troff + (16 * ks) * VP + (32 * e) * 2, VP); o[e] = MFMA32(a, pf[ks], o[e]); }
            __builtin_amdgcn_sched_barrier(0);
        }
    };
    load_tile(0, kA, vA); store_tile(0, kA, vA);
    if (NT > 1) load_tile(1, kB, vB);
    __syncthreads();
    for (int t = 0; t < NT; t += 2) {
        if (t + 2 < NT) load_tile(t + 2, kA, vA);
        if (t < my_nt) compute_tile(0, t == 0);
        if (t + 1 < NT) store_tile(1, kB, vB);
        __syncthreads();
        if (t + 1 >= NT) break;
        if (t + 3 < NT) load_tile(t + 3, kB, vB);
        if (t + 1 < my_nt) compute_tile(1, false);
        if (t + 2 < NT) store_tile(0, kA, vA);
        __syncthreads();
    }
    const float lt = half_swap_sum(lsum);
    const float inv = active ? 1.0f / lt : 0.f;
    LAS float* comb = (LAS float*)lds;
    lds_t* stg = lds + 65536;
    if (active && c == 1) {
        const float f = lam * inv;
#pragma unroll
        for (int e = 0; e < 4; ++e)
#pragma unroll
            for (int r = 0; r < 16; ++r) comb[(qg * 128 + 32 * e + crow(r, hi)) * 32 + ql] = o[e][r] * f;
    }
    __syncthreads();
    if (active && c == 0) {
        float ss = 0.f;
#pragma unroll
        for (int e = 0; e < 4; ++e)
#pragma unroll
            for (int r = 0; r < 16; ++r) { const float v = o[e][r] * inv - comb[(qg * 128 + 32 * e + crow(r, hi)) * 32 + ql]; o[e][r] = v; ss += v * v; }
        ss = half_swap_sum(ss);
        const float rs = __builtin_amdgcn_rsqf(ss * (1.0f / 128.0f) + EPS) * (1.0f - LAM_INIT);
#pragma unroll
        for (int e = 0; e < 4; ++e)
#pragma unroll
            for (int r = 0; r < 16; ++r) { const int ee = 32 * e + crow(r, hi); *(LAS bf16_t*)(stg + (qg * 32 + ql) * KP + ee * 2) = f2bf(o[e][r] * rs); }
    }
    __syncthreads();
    {
        const int nrows = kind == 0 ? 128 : 64;
        const f32x4 g0 = *(const f32x4*)(dg + (tid & 15) * 8), g1 = *(const f32x4*)(dg + (tid & 15) * 8 + 4);
        for (int cid = tid; cid < nrows * 16; cid += 512) { const int row = cid >> 4, ch = cid & 15;
            const u32x4 v = *(const LAS u32x4*)(stg + row * KP + ch * 16);
            u32x4 w; w.x = cvt_pk_bf16(bf_lo(v.x) * g0[0], bf_hi(v.x) * g0[1]); w.y = cvt_pk_bf16(bf_lo(v.y) * g0[2], bf_hi(v.y) * g0[3]);
            w.z = cvt_pk_bf16(bf_lo(v.z) * g1[0], bf_hi(v.z) * g1[1]); w.w = cvt_pk_bf16(bf_lo(v.w) * g1[2], bf_hi(v.w) * g1[3]);
            *(u32x4*)(Y + (size_t)(qrow0 + row) * DM + 512 + h * 128 + ch * 8) = w; }
    }
    __syncthreads();
}

__device__ __forceinline__ void ret_unit_rows(int sbi, int& row0, int& h) {
    if (sbi < 2048) { const int n = sbi & 63, bh = sbi >> 6; h = bh & 3; row0 = (bh >> 2) * SEQ + n * 64; }
    else { const int bh = sbi - 2048; h = bh & 3; row0 = TP + (bh >> 2) * DSEQ; }
}
__device__ __forceinline__ float ret_lg2(int h) { return __log2f(1.0f - exp2f(-5.0f - (float)h)); }
__device__ __forceinline__ void ret_seq_unit(lds_t* lds, const bf16_t* P, bf16_t* SB, float* out_ret, const float* state_in, int bh, bool is_sample) {
    const int tid = fresh_tid();
    const int lane = tid & 63, wid = __builtin_amdgcn_readfirstlane(tid >> 6), hi = lane >> 5, l31 = lane & 31;
    const int h = bh & 3, b = bh >> 2;
    const int nch = is_sample ? 1 : 64;
    const int rowbase = is_sample ? TP + b * DSEQ : b * SEQ;
    const int sb0 = is_sample ? 2048 + bh : bh * 64;
    const float lg = ret_lg2(h), dec64 = exp2f(lg * 64.0f);
    lds_t* kl = lds; lds_t* vl = lds + VTB;
    const int troff = tr_lane_off(lane, 8, VP);
    const int dt = wid >> 1, e0 = (wid & 1) * 2;
    const int srow = tid >> 4, sch = tid & 15;
    u32x4 kr[2], vr[2];
    auto load = [&](int n) {
#pragma unroll
        for (int i = 0; i < 2; ++i) { const bf16_t* src = P + (size_t)(rowbase + n * 64 + srow + 32 * i) * NIN + h * 128 + sch * 8; kr[i] = *(const u32x4*)(src + 512); vr[i] = *(const u32x4*)(src + 1024); } };
    load(0);
    f32x16 acc[2];
#pragma unroll
    for (int e = 0; e < 2; ++e)
#pragma unroll
        for (int r = 0; r < 16; ++r) acc[e][r] = is_sample ? state_in[((size_t)bh * 128 + 32 * dt + crow(r, hi)) * 128 + 32 * (e0 + e) + l31] : 0.f;
    const float dec0 = exp2f(lg * (float)(63 - srow)), dec1 = exp2f(lg * (float)(31 - srow));
    for (int n = 0; n < nch; ++n) {
#pragma unroll
        for (int i = 0; i < 2; ++i) { const int row = srow + 32 * i; const u32x4 kv = kr[i];
            const float dec = i ? dec1 : dec0;
            u32x4 ks; ks.x = cvt_pk_bf16(bf_lo(kv.x) * dec, bf_hi(kv.x) * dec); ks.y = cvt_pk_bf16(bf_lo(kv.y) * dec, bf_hi(kv.y) * dec);
            ks.z = cvt_pk_bf16(bf_lo(kv.z) * dec, bf_hi(kv.z) * dec); ks.w = cvt_pk_bf16(bf_lo(kv.w) * dec, bf_hi(kv.w) * dec);
            *(LAS u32x4*)(kl + row * VP + sch * 16) = ks; *(LAS u32x4*)(vl + row * VP + sch * 16) = vr[i]; }
        __syncthreads();
        if (n + 1 < nch) load(n + 1);
        bf16_t* ob = SB + (size_t)(sb0 + n) * 16384;
#pragma unroll
        for (int e = 0; e < 2; ++e)
#pragma unroll
            for (int r = 0; r < 16; ++r) { ob[(32 * dt + crow(r, hi)) * 128 + 32 * (e0 + e) + l31] = f2bf(acc[e][r]); acc[e][r] *= dec64; }
#pragma unroll
        for (int ks = 0; ks < 4; ++ks) {
            const bf16x8 a = tr_frag<4>(kl + troff + (16 * ks) * VP + (32 * dt) * 2, VP);
#pragma unroll
            for (int e = 0; e < 2; ++e) { const bf16x8 bb = tr_frag<4>(vl + troff + (16 * ks) * VP + (32 * (e0 + e)) * 2, VP); acc[e] = MFMA32(a, bb, acc[e]); }
        }
        __syncthreads();
    }
#pragma unroll
    for (int e = 0; e < 2; ++e)
#pragma unroll
        for (int r = 0; r < 16; ++r) out_ret[((size_t)bh * 128 + 32 * dt + crow(r, hi)) * 128 + 32 * (e0 + e) + l31] = acc[e][r];
}
__device__ __forceinline__ void ret_out_units(lds_t* lds, const bf16_t* P, const bf16_t* SB, bf16_t* Y, const float* rg, int first, int stride, int nunits) {
    int tid = threadIdx.x; asm volatile("" : "+v"(tid));
    const int lane = tid & 63, wid = __builtin_amdgcn_readfirstlane(tid >> 6), hi = lane >> 5, l31 = lane & 31;
    lds_t* ql = lds; lds_t* kl = lds + KTB; lds_t* vl = lds + 2 * KTB; lds_t* sl = lds + 2 * KTB + VTB;
    LAS float* red = (LAS float*)(lds + 2 * KTB + VTB + 128 * VP);
    u32x4 rq[2], rk[2], rv[2], rs[4];
    auto load_regs = [&](int sb) { int r0_, h_; ret_unit_rows(sb, r0_, h_);
#pragma unroll
        for (int i = 0; i < 2; ++i) { const int cid = tid + 512 * i, row = cid >> 4, ch = cid & 15;
            const bf16_t* src = P + (size_t)(r0_ + row) * NIN + h_ * 128 + ch * 8;
            rq[i] = *(const u32x4*)(src); rk[i] = *(const u32x4*)(src + 512); rv[i] = *(const u32x4*)(src + 1024); }
#pragma unroll
        for (int i = 0; i < 4; ++i) { const int cid = tid + 512 * i, row = cid >> 4, ch = cid & 15;
            rs[i] = *(const u32x4*)(SB + (size_t)sb * 16384 + row * 128 + ch * 8); } };
    if (first < nunits) load_regs(first);
  for (int sbi = first; sbi < nunits; sbi += stride) {
    int row0, h; ret_unit_rows(sbi, row0, h);
    const float lg = ret_lg2(h);
#pragma unroll
    for (int i = 0; i < 2; ++i) { const int cid = tid + 512 * i, row = cid >> 4, ch = cid & 15;
        *(LAS u32x4*)(ql + row * KP + ch * 16) = rq[i];
        *(LAS u32x4*)(kl + row * KP + ch * 16) = rk[i];
        *(LAS u32x4*)(vl + row * VP + ch * 16) = rv[i]; }
#pragma unroll
    for (int i = 0; i < 4; ++i) { const int cid = tid + 512 * i, row = cid >> 4, ch = cid & 15;
        *(LAS u32x4*)(sl + row * VP + ch * 16) = rs[i]; }
    __syncthreads();
    if (sbi + stride < nunits) load_regs(sbi + stride);
    const int et = wid & 3, it = wid >> 2;
    const int i_row = 32 * it + l31;
    bf16x8 qf[8];
#pragma unroll
    for (int ks = 0; ks < 8; ++ks) qf[ks] = *(const LAS bf16x8*)(ql + i_row * KP + (16 * ks + 8 * hi) * 2);
    f32x16 acc;
#pragma unroll
    for (int r = 0; r < 16; ++r) acc[r] = 0.f;
    const int troff8 = tr_lane_off(lane, 8, VP), troff4 = tr_lane_off(lane, 4, VP);
#pragma unroll
    for (int ks = 0; ks < 8; ++ks) { const bf16x8 a = tr_frag<4>(sl + troff8 + (16 * ks) * VP + (32 * et) * 2, VP); acc = MFMA32(a, qf[ks], acc); }
    { const float qd = exp2f(lg * (float)(i_row + 1));
#pragma unroll
      for (int r = 0; r < 16; ++r) acc[r] *= qd; }
#pragma unroll
    for (int jt = 0; jt < 2; ++jt) {
        if (jt <= it) {
            f32x16 s;
#pragma unroll
            for (int r = 0; r < 16; ++r) s[r] = 0.f;
#pragma unroll
            for (int ks = 0; ks < 8; ++ks) { const bf16x8 a = *(const LAS bf16x8*)(kl + (32 * jt + l31) * KP + (16 * ks + 8 * hi) * 2); s = MFMA32(a, qf[ks], s); }
#pragma unroll
            for (int r = 0; r < 16; ++r) { const int j = 32 * jt + crow(r, hi); const int d = i_row - j; s[r] = d >= 0 ? s[r] * exp2f(lg * (float)d) : 0.f; }
            const bf16x8 p0 = pack8(s[0], s[1], s[2], s[3], s[4], s[5], s[6], s[7]);
            const bf16x8 p1 = pack8(s[8], s[9], s[10], s[11], s[12], s[13], s[14], s[15]);
            { const bf16x8 a = tr_frag<8>(vl + troff4 + (32 * jt) * VP + (32 * et) * 2, VP); acc = MFMA32(a, p0, acc); }
            { const bf16x8 a = tr_frag<8>(vl + troff4 + (32 * jt + 16) * VP + (32 * et) * 2, VP); acc = MFMA32(a, p1, acc); }
        }
    }
    float s1 = 0.f, s2 = 0.f;
#pragma unroll
    for (int r = 0; r < 16; ++r) { s1 += acc[r]; s2 += acc[r] * acc[r]; }
    s1 = half_swap_sum(s1); s2 = half_swap_sum(s2);
    if (hi == 0) { red[((it * 4 + et) * 32 + l31) * 2] = s1; red[((it * 4 + et) * 32 + l31) * 2 + 1] = s2; }
    __syncthreads();
    float t1 = 0.f, t2 = 0.f;
#pragma unroll
    for (int e = 0; e < 4; ++e) { t1 += red[((it * 4 + e) * 32 + l31) * 2]; t2 += red[((it * 4 + e) * 32 + l31) * 2 + 1]; }
    const float mu = t1 * (1.0f / 128.0f), var = fmaxf(t2 * (1.0f / 128.0f) - mu * mu, 0.f), rs = __builtin_amdgcn_rsqf(var + EPS);
    lds_t* stg = lds;
#pragma unroll
    for (int r = 0; r < 16; ++r) { const int e = 32 * et + crow(r, hi); *(LAS bf16_t*)(stg + i_row * KP + e * 2) = f2bf((acc[r] - mu) * rs); }
    __syncthreads();
    {
        const int ch = tid & 15;
        const f32x4 g0 = *(const f32x4*)(rg + h * 128 + ch * 8), g1 = *(const f32x4*)(rg + h * 128 + ch * 8 + 4);
        u32x4 gtv[2];
#pragma unroll
        for (int i = 0; i < 2; ++i) gtv[i] = *(const u32x4*)(P + (size_t)(row0 + (tid >> 4) + 32 * i) * NIN + 1536 + h * 128 + ch * 8);
#pragma unroll
        for (int i = 0; i < 2; ++i) { const int row = (tid >> 4) + 32 * i;
            const u32x4 v = *(const LAS u32x4*)(stg + row * KP + ch * 16);
            const u32x4 gt = gtv[i];
            u32x4 w;
            w.x = cvt_pk_bf16(bf_lo(v.x) * g0[0] * fast_silu(bf_lo(gt.x)), bf_hi(v.x) * g0[1] * fast_silu(bf_hi(gt.x)));
            w.y = cvt_pk_bf16(bf_lo(v.y) * g0[2] * fast_silu(bf_lo(gt.y)), bf_hi(v.y) * g0[3] * fast_silu(bf_hi(gt.y)));
            w.z = cvt_pk_bf16(bf_lo(v.z) * g1[0] * fast_silu(bf_lo(gt.z)), bf_hi(v.z) * g1[1] * fast_silu(bf_hi(gt.z)));
            w.w = cvt_pk_bf16(bf_lo(v.w) * g1[2] * fast_silu(bf_lo(gt.w)), bf_hi(v.w) * g1[3] * fast_silu(bf_hi(gt.w)));
            *(u32x4*)(Y + (size_t)(row0 + row) * DM + h * 128 + ch * 8) = w; }
    }
    __syncthreads();
  }
}

#define XB_TMO      128
#define XB_XCNT(j)  (256  + 64 * (j))
#define XB_XSUB(j)  (1280 + 64 * (j))
#define XB_XGEN(j)  (2304 + 64 * (j))
#define XB_TOP      3328
#define XB_TOPGEN   3392
#define XCD_BAR_WORDS 3456
#define XB_SPIN_CAP (1u << 20)
constexpr int CW_BAR = 49152;
__device__ __forceinline__ unsigned xb_ld(unsigned* p)              { return __hip_atomic_load(p, __ATOMIC_RELAXED, __HIP_MEMORY_SCOPE_AGENT); }
__device__ __forceinline__ unsigned xb_add(unsigned* p, unsigned v) { return __hip_atomic_fetch_add(p, v, __ATOMIC_RELAXED, __HIP_MEMORY_SCOPE_AGENT); }
__device__ __forceinline__ unsigned xb_xcc_id() { return (unsigned)__builtin_amdgcn_s_getreg((3 << 11) | 20) & 0xFu; }
#define XB_SPIN(cond, bar) do { unsigned _sp = 0; while (cond) { __builtin_amdgcn_s_sleep(1); \
    if ((++_sp & 255u) == 0u) { if (xb_ld(&(bar)[XB_TMO])) break; if (_sp > XB_SPIN_CAP) { atomicAdd(&(bar)[XB_TMO], 1u); break; } } } } while (0)
struct XcdBarrier { unsigned* bar; unsigned x; volatile LAS unsigned* st; };
__device__ __forceinline__ XcdBarrier xcd_barrier_post(unsigned* bar, volatile LAS unsigned* st) {
    XcdBarrier b; b.bar = bar; b.x = xb_xcc_id(); b.st = st;
    if (threadIdx.x == 0) (void)xb_add(&bar[XB_XCNT(b.x)], 1u);
    return b;
}
__device__ __forceinline__ void xcd_barrier_complete(unsigned* bar, unsigned x, unsigned& nloc, unsigned& nx) {
    const unsigned G = gridDim.x * gridDim.y * gridDim.z;
    unsigned sum, cnt, mine, sp = 0u;
    for (;;) {
        sum = 0u; cnt = 0u; mine = 0u;
#pragma unroll
        for (unsigned j = 0; j < 16; ++j) { const unsigned c = xb_ld(&bar[XB_XCNT(j)]); sum += c; cnt += (c > 0u) ? 1u : 0u; mine = (j == x) ? c : mine; }
        if (sum == G) break;
        __builtin_amdgcn_s_sleep(1);
        if ((++sp & 255u) == 0u) { if (xb_ld(&bar[XB_TMO])) break; if (sp > XB_SPIN_CAP) { atomicAdd(&bar[XB_TMO], 1u); break; } }
    }
    nloc = mine > 0u ? mine : 1u; nx = cnt > 0u ? cnt : 1u;
}
__device__ __forceinline__ void xcd_barrier(const XcdBarrier& b) {
    asm volatile("s_waitcnt vmcnt(0)" ::: "memory");
    __syncthreads();
    if (threadIdx.x == 0) {
        unsigned* bar = b.bar;
        __builtin_amdgcn_s_waitcnt(0);
        unsigned nloc = b.st[0], nx = b.st[1];
        if (nloc == 0u) { xcd_barrier_complete(bar, b.x, nloc, nx); b.st[0] = nloc; b.st[1] = nx; }
        const unsigned old = xb_add(&bar[XB_XSUB(b.x)], 1u);
        const unsigned gen = old / nloc;
        if (old + 1u == (gen + 1u) * nloc) {
            __builtin_amdgcn_fence(__ATOMIC_RELEASE, "agent");
            asm volatile("s_waitcnt vmcnt(0)" ::: "memory");
            const unsigned og = xb_add(&bar[XB_TOP], 1u);
            const unsigned tg = og / nx;
            if (og + 1u == (tg + 1u) * nx) xb_add(&bar[XB_TOPGEN], 1u);
            else XB_SPIN(xb_ld(&bar[XB_TOPGEN]) == tg, bar);
            __builtin_amdgcn_fence(__ATOMIC_ACQUIRE, "agent");
            xb_add(&bar[XB_XGEN(b.x)], 1u);
            asm volatile("s_waitcnt vmcnt(0)" ::: "memory");
        } else {
            XB_SPIN(xb_ld(&bar[XB_XGEN(b.x)]) == gen, bar);
            __builtin_amdgcn_fence(__ATOMIC_ACQUIRE, "agent");
            asm volatile("s_waitcnt vmcnt(0)" ::: "memory");
        }
    }
    __syncthreads();
}
__device__ __forceinline__ bool grid_sync_fn(cg::grid_group& grid) { asm volatile("s_waitcnt vmcnt(0) lgkmcnt(0)" ::: "memory"); __builtin_amdgcn_fence(__ATOMIC_RELEASE, "workgroup"); grid.sync(); return true; }
__global__ void __launch_bounds__(512, 2) fwd_kernel(Params p) {
    extern __shared__ __attribute__((aligned(16))) unsigned char lds_raw[];
    lds_t* lds = (lds_t*)lds_raw;
    cg::grid_group grid = cg::this_grid();
    const int G = gridDim.x, bx = blockIdx.x;
    const int wave = __builtin_amdgcn_readfirstlane((int)threadIdx.x >> 6);
    const int gw = bx * 8 + wave, ngw = G * 8;
    if (threadIdx.x < 4) ((LAS unsigned*)(lds + LDS_MISC + 16))[threadIdx.x] = 0u;
    __syncthreads();
    unsigned* ctlw = (unsigned*)(p.ws + WS_CTL);
    if (bx == 0) {
        const int t_ = threadIdx.x;
        for (int i = t_; i < XCD_BAR_WORDS; i += 512) __hip_atomic_store(ctlw + CW_BAR + i, 0u, __ATOMIC_RELAXED, __HIP_MEMORY_SCOPE_AGENT);
        for (int i = t_; i < 5 * 128; i += 512) __hip_atomic_store(ctlw + CW_CNT + (i >> 7) * CW_CNT_EX + (i & 127) * 64, 0u, __ATOMIC_RELAXED, __HIP_MEMORY_SCOPE_AGENT);
        if (t_ < 2) __hip_atomic_store(ctlw + t_, 0u, __ATOMIC_RELAXED, __HIP_MEMORY_SCOPE_AGENT);
    }
    GRID_SYNC();
    const XcdBarrier xbar = xcd_barrier_post(ctlw + CW_BAR, (volatile LAS unsigned*)(lds + LDS_MISC + 16));
#define ctl ((unsigned*)(p.ws + WS_CTL))
#define RT ((float*)(p.ws + WS_RT))
#define DT ((float*)(p.ws + WS_DT))
#define WGU1 ((bf16_t*)(p.ws + WS_WGU1))
#define WD1 ((bf16_t*)(p.ws + WS_WD1))
#define WIN ((bf16_t*)(p.ws + WS_WIN))
#define WOUT ((bf16_t*)(p.ws + WS_WOUT))
#define WGU2 ((bf16_t*)(p.ws + WS_WGU2))
#define WD2 ((bf16_t*)(p.ws + WS_WD2))
#define H ((bf16_t*)(p.ws + WS_H))
#define D ((bf16_t*)(p.ws + WS_D))
#define SB ((bf16_t*)(p.ws + WS_D))
#define KC ((bf16_t*)(p.ws + WS_KC))
#define VC ((bf16_t*)(p.ws + WS_VC))
#define BIG ((bf16_t*)(p.ws + WS_BIG))
#define X (p.out + OY)
#define PART ((float*)(p.ws + WS_PART))
#define X1B ((bf16_t*)p.out)
#define X2B ((bf16_t*)(p.ws + WS_D))
#define SLOT(ex) ((float*)(p.ws + WS_SLOT) + (size_t)(ex) * 128 * 256 * 4)
#define CNT(ex) (ctl + CW_CNT + (ex) * CW_CNT_EX)
    constexpr int I_GU = 16 * 176, I_D = 44 * 32, I_IN = 16 * 112, I_OUT = 16 * 32, NITEMS = 2 * I_GU + 2 * I_D + I_IN + I_OUT;
    auto convert_items = [&](int lo, int hi, int w0, int nw) {
        const int lane = fresh_tid() & 63;
        LAS float* scr = (LAS float*)(lds + wave * 16384);
        for (int it = lo + w0; it < hi; it += nw) {
            int r = it;
            if (r < 2 * I_GU) { const int f = r >= I_GU; r -= f * I_GU; const int kb = r / 176, nb = r % 176, isup = (nb >> 2) & 1;
                const float* W = p.in[f ? (isup ? 22 : 21) : (isup ? 7 : 6)];
                transpose_item(W, DM, DFF, f ? WGU2 : WGU1, scr, 64 * kb, 32 * nb, lane, [](int nd) { return (nd >> 8) * 128 + (nd & 127); }); continue; }
            r -= 2 * I_GU;
            if (r < 2 * I_D) { const int f = r >= I_D; r -= f * I_D; transpose_item(p.in[f ? 23 : 8], DFF, DM, f ? WD2 : WD1, scr, 64 * (r / 32), 32 * (r % 32), lane, [](int n) { return n; }); continue; }
            r -= 2 * I_D;
            if (r < I_IN) { transpose_item(p.in[11], DM, NIN, WIN, scr, 64 * (r / 112), 32 * (r % 112), lane, [](int n) { return win_srccol(n); }); continue; }
            r -= I_IN;
            transpose_item(p.in[18], DM, DM, WOUT, scr, 64 * (r / 32), 32 * (r % 32), lane, [](int n) { return n; });
        }
    };
    auto convert_cache = [&](size_t t0, size_t nt) {
        const size_t n8 = (size_t)8 * PAST * 512 / 8;
#pragma unroll 1
        for (int isv = 0; isv < 2; ++isv) {
            const f32x4* s = (const f32x4*)(p.in[isv ? 4 : 3]); u32x4* d = (u32x4*)(isv ? VC : KC);
#pragma unroll 1
            for (size_t i = t0; i < n8; i += 4 * nt) {
                f32x4 a[4], c[4];
#pragma unroll
                for (int u = 0; u < 4; ++u) { const size_t j = i + u * nt; if (j < n8) { a[u] = s[2 * j]; c[u] = s[2 * j + 1]; } }
#pragma unroll
                for (int u = 0; u < 4; ++u) { const size_t j = i + u * nt; if (j < n8) {
                    u32x4 w; w.x = cvt_pk_bf16(a[u][0], a[u][1]); w.y = cvt_pk_bf16(a[u][2], a[u][3]); w.z = cvt_pk_bf16(c[u][0], c[u][1]); w.w = cvt_pk_bf16(c[u][2], c[u][3]);
                    d[j] = w; } }
            }
        }
    };
    PH(0) {
        const int tid = fresh_tid(), lane = tid & 63;
        convert_items(0, I_GU, gw, ngw);
        row_phase(p.in[0], p.in[1], nullptr, nullptr, 0, nullptr, 0.f, nullptr, p.in[5], H, gw, ngw);
        { const int gt = bx * 512 + tid, ngt = G * 512;
          for (int i = gt; i < NPOS * 64; i += ngt) { const int pos = i >> 6, k = i & 63; const float inv = powf(10000.0f, -(float)k * (2.0f / 128.0f)); const float ang = (float)pos * inv;
              RT[2 * i] = cosf(ang); RT[2 * i + 1] = sinf(ang); }
          for (int i = gt; i < NPOS * 8; i += ngt) { const int pos = i >> 3, k = i & 7; const float inv = powf(500000.0f, -(float)k * (2.0f / 16.0f)); const float ang = (float)pos * inv;
              DT[2 * i] = cosf(ang); DT[2 * i + 1] = sinf(ang); } }
        if (bx == 0 && wave == 0) {
            const float a = wave_sum(p.in[13][lane] * p.in[14][lane]), b2 = wave_sum(p.in[15][lane] * p.in[16][lane]);
            if (lane == 0) ((float*)ctl)[64] = expf(a) - expf(b2) + LAM_INIT;
        }
    }
    XSYNC();
    PH(1) { pg8::Gemm g{H, WGU1, T, 2 * DFF, DM, DM}; pg8::StaticOrder S; S.init(T, 2 * DFF, G, bx); EpiSwiglu E{BIG}; pg8::gemm_phase(lds, g, S, E);
      { const int rem = ((T / 256) * (2 * DFF / 256)) % G;
        if (bx >= rem) convert_items(I_GU, NITEMS, (bx - rem) * 8 + wave, (G - rem) * 8); } }
    XSYNC();
    PH(2) { { pg8::Gemm g{BIG, WD1, TP, DM, DFF, DFF}; pg8::Order4 S; S.init(TP, G, bx); EpiResNorm<false, true> E{p.in[0], X1B, H, p.in[9], p.in[10], 0.5f, RowStat{SLOT(0), CNT(0)}, RowStat{SLOT(1), CNT(1)}, lds}; pg8::gemm_phase(lds, g, S, E); }
      { pg8::Gemm g{BIG + (size_t)TP * DFF, WD1, TS, DM, DFF, 256}; pg8::SplitOrder S; S.init(TS, DM, 11, G, bx); EpiPart E{PART}; pg8::gemm_phase(lds, g, S, E); } }
    XSYNC();
    PH(3) row_phase(p.in[0], p.in[1], D, PART, 11, p.in[9], 0.5f, X, p.in[10], H, gw, ngw, TP);
    XSYNC();
    PH(4) { pg8::Gemm g{H, WIN, T, NIN, DM, DM}; pg8::StaticOrder S; S.init(T, NIN, G, bx); EpiIn E{BIG, p.out, RT, DT}; pg8::gemm_phase(lds, g, S, E);
      { const int rem = ((T / 256) * (NIN / 256)) % G;
        if (bx >= rem) convert_cache((size_t)(bx - rem) * 512 + fresh_tid(), (size_t)(G - rem) * 512); } }
    XSYNC();
    PH(5) {
        const float lam = ((const float*)ctl)[64];
        const int tid = fresh_tid();
        LAS int* misc = (LAS int*)(lds + LDS_MISC);
        constexpr int NR_P = 32, NA_S = 32, NA_P = 1024, NR_S = 32;
        for (;;) {
            if (tid == 0) misc[0] = (int)atomicAdd(&ctl[rep_], 1u);
            __syncthreads();
            const int item = misc[0];
            __syncthreads();
            if (item >= NR_P + NA_S + NA_P + NR_S) break;
            if (item < NR_P) ret_seq_unit(lds, BIG, SB, p.out + ORET_P, nullptr, item, false);
            else if (item < NR_P + NA_S + NA_P) {
                const int ui = __builtin_amdgcn_readfirstlane(item) - NR_P; const int kind = ui < NA_S ? 1 : 0; const int r = ui - NA_S;
                const int qb = kind ? 0 : 31 - (r >> 5), bh = kind ? ui : (r & 31);
                attn_unit(lds, BIG, KC, VC, H, p.in[17], lam, kind, bh >> 2, bh & 3, qb); }
            else ret_seq_unit(lds, BIG, SB, p.out + ORET_S, p.in[2], item - NR_P - NA_S - NA_P, true);
        }
    }
    XSYNC();
    PH(7) ret_out_units(lds, BIG, SB, H, p.in[12], bx, G, 2080);
    XSYNC();
    PH(8) { { pg8::Gemm g{H, WOUT, TP, DM, DM, DM}; pg8::Order4 S; S.init(TP, G, bx); EpiResNorm<true, true> E{X1B, X2B, H, p.in[19], p.in[20], 1.0f, RowStat{SLOT(2), CNT(2)}, RowStat{SLOT(3), CNT(3)}, lds}; pg8::gemm_phase(lds, g, S, E); }
      { pg8::Gemm g{H + (size_t)TP * DM, WOUT, TS, DM, DM, 256}; pg8::SplitOrder S; S.init(TS, DM, 4, G, bx); EpiPart E{PART}; pg8::gemm_phase(lds, g, S, E); } }
    XSYNC();
    PH(9) row_phase(X, X + (size_t)TP * DM, D, PART, 4, p.in[19], 1.0f, X, p.in[20], H, gw, ngw, TP);
    XSYNC();
    PH(10) { pg8::Gemm g{H, WGU2, T, 2 * DFF, DM, DM}; pg8::StaticOrder S; S.init(T, 2 * DFF, G, bx); EpiSwiglu E{BIG}; pg8::gemm_phase(lds, g, S, E); }
    XSYNC();
    PH(11) { { pg8::Gemm g{BIG, WD2, TP, DM, DFF, DFF}; pg8::Order4 S; S.init(TP, G, bx); EpiResNorm<true, false> E{X2B, X, nullptr, p.in[24], nullptr, 0.5f, RowStat{SLOT(4), CNT(4)}, RowStat{SLOT(4), CNT(4)}, lds}; pg8::gemm_phase(lds, g, S, E); }
      { pg8::Gemm g{BIG + (size_t)TP * DFF, WD2, TS, DM, DFF, 256}; pg8::SplitOrder S; S.init(TS, DM, 11, G, bx); EpiPart E{PART}; pg8::gemm_phase(lds, g, S, E); } }
    XSYNC();
    PH(12) row_phase(X, X + (size_t)TP * DM, D, PART, 11, p.in[24], 0.5f, X, nullptr, nullptr, gw, ngw, TP);
}

#undef ctl
#undef RT
#undef DT
#undef WGU1
#undef WD1
#undef WIN
#undef WOUT
#undef WGU2
#undef WD2
#undef H
#undef D
#undef SB
#undef KC
#undef VC
#undef BIG
#undef X
#undef PART
#undef X1B
#undef X2B
#undef SLOT
#undef CNT
extern "C" void kernel_launch(void* const* d_in, const int* in_sizes, int n_in, void* d_out, int out_size, void* d_ws, size_t ws_size, hipStream_t stream) {
    static int grid = 0;
    if (grid == 0) {
        int dev = 0, cus = 0, per_cu = 0;
        (void)hipGetDevice(&dev);
        (void)hipDeviceGetAttribute(&cus, hipDeviceAttributeMultiprocessorCount, dev);
        if (hipFuncSetAttribute((const void*)fwd_kernel, hipFuncAttributeMaxDynamicSharedMemorySize, LDS_BYTES) != hipSuccess) fprintf(stderr, "kernel_launch: hipFuncSetAttribute failed\n");
        (void)hipOccupancyMaxActiveBlocksPerMultiprocessor(&per_cu, (const void*)fwd_kernel, 512, LDS_BYTES);
        if (per_cu < 1) { fprintf(stderr, "kernel_launch: occupancy query returned %d\n", per_cu); per_cu = 1; }
        (void)hipGetLastError();
        grid = cus * per_cu;
    }
    Params p{};
    for (int i = 0; i < 25; ++i) p.in[i] = (const float*)d_in[i];
    p.out = (float*)d_out; p.ws = (unsigned char*)d_ws;
    void* args[] = {&p};
    hipError_t e = hipLaunchCooperativeKernel((const void*)fwd_kernel, dim3(grid), dim3(512), args, LDS_BYTES, stream);
    if (e != hipSuccess) fprintf(stderr, "cooperative launch failed: %s (grid %d)\n", hipGetErrorString(e), grid);
}
```
